# Optimizing an MI355X kernel written in HIP

```python
import math
import jax, jax.numpy as jnp
from jax import lax
import numpy as np

D_MODEL = 1024
BATCH = 1
SEQ = 16384
DEPTH = 4

N_A = DEPTH // 2
N_B = DEPTH - N_A
Q_BLOCK = 128
RMS_EPS = 1e-6

FOX_HEADS = 16
FOX_HEAD_DIM = D_MODEL // FOX_HEADS
FOX_WIDTH = FOX_HEADS * FOX_HEAD_DIM

MLA_HEADS = 16
MLA_NOPE = 64
MLA_ROPE = 32
MLA_V = 64
KV_RANK = 4 * MLA_V
Q_RANK = 12 * MLA_V
ROPE_THETA = 10000.0

D_FF = ((8 * D_MODEL // 3 + 255) // 256) * 256

kernel_name = "yoco_fox_mla_hybrid"


def rmsnorm(x, g):
    xf = x.astype(jnp.float32)
    inv = lax.rsqrt(jnp.mean(xf * xf, axis=-1, keepdims=True) + RMS_EPS)
    return (xf * inv).astype(x.dtype) * g


def rope(x, positions):
    d = x.shape[-1]
    inv_freq = ROPE_THETA ** (-jnp.arange(0, d // 2, dtype=jnp.float32) * 2.0 / d)
    ang = positions.astype(jnp.float32)[..., None] * inv_freq
    cos = jnp.cos(ang)[:, :, None, :]
    sin = jnp.sin(ang)[:, :, None, :]
    xf = x.astype(jnp.float32)
    x1, x2 = xf[..., : d // 2], xf[..., d // 2:]
    out = jnp.concatenate([x1 * cos - x2 * sin, x1 * sin + x2 * cos], axis=-1)
    return out.astype(x.dtype)


def causal_block_attention(q, k, v, scale, log_f_cum=None):
    B, S, H, dq = q.shape
    nb = S // Q_BLOCK
    qb = q.reshape(B, nb, Q_BLOCK, H, dq).transpose(1, 0, 2, 3, 4)
    k_pos = jnp.arange(S)
    if log_f_cum is not None:
        cq_blocks = log_f_cum.reshape(B, nb, Q_BLOCK, H).transpose(1, 0, 2, 3)
        ck = log_f_cum.transpose(0, 2, 1)
    else:
        cq_blocks, ck = None, None

    def one_block(args):
        i, q_blk, cq = args
        s = jnp.einsum('bqhd,bkhd->bhqk', q_blk, k,
                       preferred_element_type=jnp.float32) * scale
        if cq is not None:
            s = s + (cq.transpose(0, 2, 1)[..., None] - ck[:, :, None, :])
        q_pos = i * Q_BLOCK + jnp.arange(Q_BLOCK)
        mask = k_pos[None, :] <= q_pos[:, None]
        s = jnp.where(mask[None, None], s, -jnp.inf)
        p = jax.nn.softmax(s, axis=-1)
        return jnp.einsum('bhqk,bkhd->bqhd', p.astype(v.dtype), v)

    out = lax.map(one_block, (jnp.arange(nb), qb, cq_blocks))
    return out.transpose(1, 0, 2, 3, 4).reshape(B, S, H, v.shape[-1])


def fox_attention(xn, w_in, b_f, w_o):
    B, S, _ = xn.shape
    proj = xn @ w_in
    q = proj[..., :FOX_WIDTH].reshape(B, S, FOX_HEADS, FOX_HEAD_DIM)
    k = proj[..., FOX_WIDTH:2 * FOX_WIDTH].reshape(B, S, FOX_HEADS, FOX_HEAD_DIM)
    v = proj[..., 2 * FOX_WIDTH:3 * FOX_WIDTH].reshape(B, S, FOX_HEADS, FOX_HEAD_DIM)
    f_logit = proj[..., 3 * FOX_WIDTH:] + b_f
    log_f = jax.nn.log_sigmoid(f_logit.astype(jnp.float32))
    cum = jnp.cumsum(log_f, axis=1)
    o = causal_block_attention(q, k, v, 1.0 / math.sqrt(FOX_HEAD_DIM), cum)
    return o.reshape(B, S, FOX_WIDTH) @ w_o


def mla_shared_kv(h, positions, kv_norm, w_kv_a, ckv_norm, w_uk, w_uv):
    B, S, _ = h.shape
    hn = rmsnorm(h, kv_norm)
    a = hn @ w_kv_a
    c_kv = rmsnorm(a[..., :KV_RANK], ckv_norm)
    k_rope = rope(a[..., KV_RANK:][:, :, None, :], positions)
    k_nope = jnp.einsum('bsr,rhd->bshd', c_kv, w_uk)
    v = jnp.einsum('bsr,rhd->bshd', c_kv, w_uv)
    k = jnp.concatenate(
        [k_nope, jnp.broadcast_to(k_rope, (B, S, MLA_HEADS, MLA_ROPE))], axis=-1)
    return k, v


def mla_attention(xn, positions, k, v, w_dq, cq_norm, w_uq, w_o):
    B, S, _ = xn.shape
    c_q = rmsnorm(xn @ w_dq, cq_norm)
    q = (c_q @ w_uq).reshape(B, S, MLA_HEADS, MLA_NOPE + MLA_ROPE)
    q = jnp.concatenate([q[..., :MLA_NOPE], rope(q[..., MLA_NOPE:], positions)], axis=-1)
    o = causal_block_attention(q, k, v, 1.0 / math.sqrt(MLA_NOPE + MLA_ROPE))
    return o.reshape(B, S, MLA_HEADS * MLA_V) @ w_o


def swiglu(xn, w_gate, w_up, w_down):
    return (jax.nn.silu(xn @ w_gate) * (xn @ w_up)) @ w_down


def setup_inputs(seed: int = 0) -> dict:
    key = jax.random.key(seed)
    ks = jax.random.split(key, 24)

    def nrm(k, shape, fan_in):
        return jax.random.normal(k, shape, jnp.float32) * (fan_in ** -0.5)

    def gain(k, shape):
        return 1.0 + 0.02 * jax.random.normal(k, shape, jnp.float32)

    x = jax.random.normal(ks[0], (BATCH, SEQ, D_MODEL), jnp.float32)
    positions = jnp.broadcast_to(jnp.arange(SEQ, dtype=jnp.int32), (BATCH, SEQ))
    return {
        "x": x,
        "positions": positions,
        "attn_norm": gain(ks[1], (DEPTH, D_MODEL)),
        "ffn_norm": gain(ks[2], (DEPTH, D_MODEL)),
        "w_gate": nrm(ks[3], (DEPTH, D_MODEL, D_FF), D_MODEL),
        "w_up": nrm(ks[4], (DEPTH, D_MODEL, D_FF), D_MODEL),
        "w_down": nrm(ks[5], (DEPTH, D_FF, D_MODEL), D_FF),
        "fox_w_in": nrm(ks[6], (N_A, D_MODEL, 3 * FOX_WIDTH + FOX_HEADS), D_MODEL),
        "fox_b_f": 3.0 + 0.5 * jax.random.normal(ks[7], (N_A, FOX_HEADS), jnp.float32),
        "fox_w_o": nrm(ks[8], (N_A, FOX_WIDTH, D_MODEL), FOX_WIDTH),
        "kv_norm": gain(ks[9], (D_MODEL,)),
        "w_kv_a": nrm(ks[10], (D_MODEL, KV_RANK + MLA_ROPE), D_MODEL),
        "ckv_norm": gain(ks[11], (KV_RANK,)),
        "w_uk": nrm(ks[12], (KV_RANK, MLA_HEADS, MLA_NOPE), KV_RANK),
        "w_uv": nrm(ks[13], (KV_RANK, MLA_HEADS, MLA_V), KV_RANK),
        "mla_w_dq": nrm(ks[14], (N_B, D_MODEL, Q_RANK), D_MODEL),
        "cq_norm": gain(ks[15], (N_B, Q_RANK)),
        "mla_w_uq": nrm(ks[16], (N_B, Q_RANK, MLA_HEADS * (MLA_NOPE + MLA_ROPE)), Q_RANK),
        "mla_w_o": nrm(ks[17], (N_B, MLA_HEADS * MLA_V, D_MODEL), MLA_HEADS * MLA_V),
        "final_norm": gain(ks[18], (D_MODEL,)),
    }


def reference(x, positions, attn_norm, ffn_norm, w_gate, w_up, w_down,
              fox_w_in, fox_b_f, fox_w_o, kv_norm, w_kv_a, ckv_norm, w_uk, w_uv,
              mla_w_dq, cq_norm, mla_w_uq, mla_w_o, final_norm):
    h = x
    k_shared, v_shared = None, None
    for l in range(DEPTH):
        if l == N_A:
            k_shared, v_shared = mla_shared_kv(h, positions, kv_norm, w_kv_a,
                                               ckv_norm, w_uk, w_uv)
        xn = rmsnorm(h, attn_norm[l])
        if l < N_A:
            h = h + fox_attention(xn, fox_w_in[l], fox_b_f[l], fox_w_o[l])
        else:
            j = l - N_A
            h = h + mla_attention(xn, positions, k_shared, v_shared,
                                  mla_w_dq[j], cq_norm[j], mla_w_uq[j], mla_w_o[j])
        h = h + swiglu(rmsnorm(h, ffn_norm[l]), w_gate[l], w_up[l], w_down[l])
    return rmsnorm(h, final_norm)
```

```cpp
#include <hip/hip_runtime.h>
#include <hip/hip_cooperative_groups.h>
#include <cstdio>
#include <cstdint>
namespace cg = cooperative_groups;
namespace pg8 {
#define PG8_LAS __attribute__((address_space(3)))
typedef unsigned short bf16_t;
typedef short bf16x8 __attribute__((ext_vector_type(8)));
typedef float f32x4 __attribute__((ext_vector_type(4)));
typedef unsigned u32x4 __attribute__((ext_vector_type(4)));
constexpr int BM = 256, BK = 64, HALF = 128, HTB = HALF * BK * 2  , STAGE_BYTES = 8 * HTB, NXCD = 8, WGM = 8;

__host__ __device__ __forceinline__ int lds_byte(int r, int c) { const int st = (r >> 4) * 2 + (c >> 5), rr = r & 15, cc = c & 31, ob = rr * 64 + cc * 2; return st * 1024 + (ob ^ (((ob >> 9) & 1) << 5)); }
__host__ __device__ __forceinline__ void stage_rc(int b, int& R, int& C) { const int st = b / 1024, sb = b % 1024, swz = sb ^ (((sb >> 9) & 1) << 5); R = (st >> 1) * 16 + swz / 64; C = (st & 1) * 32 + (swz % 64) / 2; }
__host__ __device__ __forceinline__ int perm32(int rho) { const int n = rho >> 4, i = rho & 15; return 8 * (i >> 2) + 4 * n + (i & 3); }

struct Unit { int pm, pn; };
struct Gemm { const bf16_t* A; const bf16_t* Bt; int M, N, K; };

struct StaticOrder {
    int nM, nN, nwg, G, c;
    __host__ __device__ void init(int M, int N, int G_, int c_) { nM = M / BM; nN = N / BM; nwg = nM * nN; G = G_; c = c_; }
    __host__ __device__ bool next(int i, Unit& u) const {
        const long L = (long)i * G + c; if (L >= nwg) return false;
        int wgid = (int)L; { const int q = nwg / NXCD, r = nwg % NXCD, xcd = wgid % NXCD, off = wgid / NXCD; wgid = (xcd < r ? xcd * (q + 1) : r * (q + 1) + (xcd - r) * q) + off; }
        const int nig = WGM * nN, gid = wgid / nig, fm = gid * WGM, gsz = (nM - fm) < WGM ? (nM - fm) : WGM;
        u.pm = fm + ((wgid % nig) % gsz); u.pn = (wgid % nig) / gsz; return true;
    }
    __device__ __forceinline__ void a_ready(const Unit&) const {}
    __device__ __forceinline__ void done(const Unit&) const {}
};

__device__ __forceinline__ unsigned cvt_pk_bf16(float lo, float hi) { unsigned r; asm volatile("v_cvt_pk_bf16_f32 %0, %1, %2" : "=v"(r) : "v"(lo), "v"(hi)); return r; }
typedef float f32x2 __attribute__((ext_vector_type(2)));
typedef unsigned u32x2 __attribute__((ext_vector_type(2)));
__device__ __forceinline__ float row_inv(const float* ssq, int row, int nvec, float inv_n) {
    if (!ssq) return 1.f;
    const f32x4* p = (const f32x4*)(ssq + (size_t)row * 16); f32x4 s = p[0];
    if (nvec > 1) s += p[1];
    if (nvec > 2) s += p[2];
    if (nvec > 3) s += p[3];
    return 1.0f / sqrtf(((s.x + s.y) + (s.z + s.w)) * inv_n + 1e-6f);
}
struct EpiBf16S {
    static constexpr bool PERM = true, AFTER_DRAIN = false;
    bf16_t* O; int ldc; int split_cols; size_t split_stride; float scale0; int nscale;
    int fgate_pn; float* logit;
    const float* ssq; int nvec; float inv_n;
    int kmax_tmax; unsigned* kmax;
    __device__ __forceinline__ void operator()(const f32x4 (&acc)[2][2][4][2], const Unit& u, int wr, int wc, int fr, int fq) const {
        const int row0 = u.pm * BM + wr * 64 + fr;
        if (u.pn == fgate_pn) {
            if (wc == 0 && fq < 2) {
#pragma unroll
                for (int ai = 0; ai < 2; ++ai)
#pragma unroll
                    for (int m = 0; m < 4; ++m) { const int row = row0 + ai * HALF + m * 16; const float rs = row_inv(ssq, row, nvec, inv_n); float* lp = logit + (size_t)row * 16 + 8 * fq;
                        *(f32x4*)lp = acc[ai][0][m][0] * rs; *(f32x4*)(lp + 4) = acc[ai][0][m][1] * rs; }
            }
            return;
        }
        int colt = u.pn * BM; bf16_t* base = O; int t = 0;
        if (split_cols) { t = colt / split_cols; base += (size_t)t * split_stride; colt -= t * split_cols; }
        const float sc = (t < nscale) ? scale0 : 1.f;
        const int col0 = colt + wc * 32 + 8 * fq; float mx[2] = {0.f, 0.f};
#pragma unroll
        for (int ai = 0; ai < 2; ++ai)
#pragma unroll
            for (int m = 0; m < 4; ++m) { const int row = row0 + ai * HALF + m * 16; const float rs = row_inv(ssq, row, nvec, inv_n) * sc; bf16_t* rowp = base + (size_t)row * ldc + col0;
#pragma unroll
                for (int bj = 0; bj < 2; ++bj) { f32x4 v0 = acc[ai][bj][m][0] * rs, v1 = acc[ai][bj][m][1] * rs;
                    if (kmax && t <= kmax_tmax) { float sb = ((v0[0] * v0[0] + v0[1] * v0[1]) + (v0[2] * v0[2] + v0[3] * v0[3])) + ((v1[0] * v1[0] + v1[1] * v1[1]) + (v1[2] * v1[2] + v1[3] * v1[3]));
                        sb += __shfl_xor(sb, 16); sb += __shfl_xor(sb, 32); mx[bj] = fmaxf(mx[bj], sb); }
                    u32x4 w; w.x = cvt_pk_bf16(v0[0], v0[1]); w.y = cvt_pk_bf16(v0[2], v0[3]); w.z = cvt_pk_bf16(v1[0], v1[1]); w.w = cvt_pk_bf16(v1[2], v1[3]);
                    *(u32x4*)(rowp + bj * HALF) = w; } }
        if (kmax && t <= kmax_tmax) {
#pragma unroll
            for (int bj = 0; bj < 2; ++bj) { float mm = mx[bj];
#pragma unroll
                for (int o = 1; o < 16; o <<= 1) mm = fmaxf(mm, __shfl_xor(mm, o));
                if (fr == 0 && fq == 0) { unsigned* kp = kmax + (4 * u.pn + 2 * bj + (wc >> 1)) * 2 + (wc & 1); const unsigned um = __float_as_uint(mm);
                    if (um > __hip_atomic_load(kp, __ATOMIC_RELAXED, __HIP_MEMORY_SCOPE_AGENT)) atomicMax(kp, um); } }
        }
    }
};
__device__ __forceinline__ float silu_mul(float g, float u) { return g * __builtin_amdgcn_rcpf(1.f + __builtin_amdgcn_exp2f(-1.4426950408889634f * g)) * u; }
struct EpiSwiGLU {
    static constexpr bool PERM = true, AFTER_DRAIN = false;
    bf16_t* O; int ldc; const float* ssq;
    __device__ __forceinline__ void operator()(const f32x4 (&acc)[2][2][4][2], const Unit& u, int wr, int wc, int fr, int fq) const {
        const int row0 = u.pm * BM + wr * 64 + fr; const int col0 = u.pn * HALF + wc * 32 + 8 * fq;
#pragma unroll
        for (int ai = 0; ai < 2; ++ai)
#pragma unroll
            for (int m = 0; m < 4; ++m) { const int row = row0 + ai * HALF + m * 16; const float rs = row_inv(ssq, row, 4, 1.f / 1024.f); bf16_t* rowp = O + (size_t)row * ldc + col0;
                const f32x4 g0 = acc[ai][0][m][0] * rs, g1 = acc[ai][0][m][1] * rs, u0 = acc[ai][1][m][0] * rs, u1 = acc[ai][1][m][1] * rs;
                u32x4 w; w.x = cvt_pk_bf16(silu_mul(g0[0], u0[0]), silu_mul(g0[1], u0[1])); w.y = cvt_pk_bf16(silu_mul(g0[2], u0[2]), silu_mul(g0[3], u0[3]));
                w.z = cvt_pk_bf16(silu_mul(g1[0], u1[0]), silu_mul(g1[1], u1[1])); w.w = cvt_pk_bf16(silu_mul(g1[2], u1[2]), silu_mul(g1[3], u1[3]));
                *(u32x4*)rowp = w; }
    }
};
struct EpiResAdd {
    static constexpr bool PERM = true, AFTER_DRAIN = false;
    bf16_t* hb; float* ssq_out; int ldc;
    __device__ __forceinline__ void operator()(const f32x4 (&acc)[2][2][4][2], const Unit& u, int wr, int wc, int fr, int fq) const {
        const int row0 = u.pm * BM + wr * 64 + fr; const int col0 = u.pn * BM + wc * 32 + 8 * fq;
#pragma unroll
        for (int ai = 0; ai < 2; ++ai)
#pragma unroll
            for (int m = 0; m < 4; ++m) { const int row = row0 + ai * HALF + m * 16; bf16_t* hp = hb + (size_t)row * ldc + col0; float ss = 0.f;
#pragma unroll
                for (int bj = 0; bj < 2; ++bj) { u32x4* p = (u32x4*)(hp + bj * HALF); const u32x4 hw = *p;
                    f32x4 v0 = acc[ai][bj][m][0], v1 = acc[ai][bj][m][1];
                    v0[0] += __uint_as_float(hw.x << 16); v0[1] += __uint_as_float(hw.x & 0xffff0000u); v0[2] += __uint_as_float(hw.y << 16); v0[3] += __uint_as_float(hw.y & 0xffff0000u);
                    v1[0] += __uint_as_float(hw.z << 16); v1[1] += __uint_as_float(hw.z & 0xffff0000u); v1[2] += __uint_as_float(hw.w << 16); v1[3] += __uint_as_float(hw.w & 0xffff0000u);
                    ss += ((v0[0] * v0[0] + v0[1] * v0[1]) + (v0[2] * v0[2] + v0[3] * v0[3])) + ((v1[0] * v1[0] + v1[1] * v1[1]) + (v1[2] * v1[2] + v1[3] * v1[3]));
                    u32x4 w; w.x = cvt_pk_bf16(v0[0], v0[1]); w.y = cvt_pk_bf16(v0[2], v0[3]); w.z = cvt_pk_bf16(v1[0], v1[1]); w.w = cvt_pk_bf16(v1[2], v1[3]); *p = w; }
                ss += __shfl_xor(ss, 16); ss += __shfl_xor(ss, 32);
                if (fq == 0) ssq_out[(size_t)row * 16 + 4 * u.pn + wc] = ss; }
    }
};
struct EpiNormOut {
    static constexpr bool PERM = false, AFTER_DRAIN = false;
    bf16_t* O; int ldc; const float* ssq_in; float* ssq_out; int rope_pn; const float* cs; bf16_t* KR; unsigned* kmax;
    __device__ __forceinline__ void operator()(const f32x4 (&acc)[2][2][4][2], const Unit& u, int wr, int wc, int fr, int fq) const {
        const int row0 = u.pm * BM + wr * 64 + fr;
        if (u.pn == rope_pn) {
            if (wc == 0) { float mr = 0.f;
#pragma unroll
                for (int ai = 0; ai < 2; ++ai)
#pragma unroll
                    for (int m = 0; m < 4; ++m) { const int row = row0 + ai * HALF + m * 16; const float rs = row_inv(ssq_in, row, 4, 1.f / 1024.f);
                        const f32x4 x1 = acc[ai][0][m][0] * rs, x2 = acc[ai][0][m][1] * rs; const f32x4 c = *(const f32x4*)(cs + (size_t)row * 32 + 4 * fq), s = *(const f32x4*)(cs + (size_t)row * 32 + 16 + 4 * fq);
                        const f32x4 o1 = x1 * c - x2 * s, o2 = x1 * s + x2 * c;
                        u32x2 w1, w2; w1.x = cvt_pk_bf16(o1[0], o1[1]); w1.y = cvt_pk_bf16(o1[2], o1[3]); w2.x = cvt_pk_bf16(o2[0], o2[1]); w2.y = cvt_pk_bf16(o2[2], o2[3]);
                        *(u32x2*)(KR + (size_t)row * 32 + 4 * fq) = w1; *(u32x2*)(KR + (size_t)row * 32 + 16 + 4 * fq) = w2;
                        float sb = ((o1[0] * o1[0] + o1[1] * o1[1]) + (o1[2] * o1[2] + o1[3] * o1[3])) + ((o2[0] * o2[0] + o2[1] * o2[1]) + (o2[2] * o2[2] + o2[3] * o2[3]));
                        sb += __shfl_xor(sb, 16); sb += __shfl_xor(sb, 32); mr = fmaxf(mr, sb); }
#pragma unroll
                for (int o = 1; o < 16; o <<= 1) mr = fmaxf(mr, __shfl_xor(mr, o));
                if (kmax && fr == 0 && fq == 0) { const unsigned um = __float_as_uint(mr); if (um > __hip_atomic_load(kmax + 32, __ATOMIC_RELAXED, __HIP_MEMORY_SCOPE_AGENT)) atomicMax(kmax + 32, um); }
            }
            return;
        }
        const int col0 = u.pn * BM + wc * 32 + 4 * fq;
#pragma unroll
        for (int ai = 0; ai < 2; ++ai)
#pragma unroll
            for (int m = 0; m < 4; ++m) { const int row = row0 + ai * HALF + m * 16; const float rs = row_inv(ssq_in, row, 4, 1.f / 1024.f); bf16_t* op = O + (size_t)row * ldc + col0; float ss = 0.f;
#pragma unroll
                for (int bj = 0; bj < 2; ++bj)
#pragma unroll
                    for (int n = 0; n < 2; ++n) { const f32x4 v = acc[ai][bj][m][n] * rs; ss += (v[0] * v[0] + v[1] * v[1]) + (v[2] * v[2] + v[3] * v[3]);
                        u32x2 w; w.x = cvt_pk_bf16(v[0], v[1]); w.y = cvt_pk_bf16(v[2], v[3]); *(u32x2*)(op + bj * HALF + n * 16) = w; }
                ss += __shfl_xor(ss, 16); ss += __shfl_xor(ss, 32);
                if (fq == 0) ssq_out[(size_t)row * 16 + 4 * u.pn + wc] = ss; }
    }
};
template <class Epi, class Sched, bool ALIGN_EPI = false, bool SP2 = false>
__device__ __forceinline__ void gemm_phase(PG8_LAS unsigned char* lds, const Gemm g, const Sched& S, const Epi& E) {
    int tid_o = threadIdx.x; asm volatile("" : "+v"(tid_o)); const int tid = tid_o, wid = __builtin_amdgcn_readfirstlane(tid >> 6), lane = tid & 63, wr = wid >> 2, wc = wid & 3, fr = lane & 15, fq = lane >> 4;
    const int K = g.K, nt = K / BK;
    unsigned voffA[2], voffB[2];
#pragma unroll
    for (int i = 0; i < 2; ++i) { int R, C; stage_rc(tid * 16 + i * 8192, R, C); const int Rb = Epi::PERM ? ((R & ~31) + perm32(R & 31)) : R;
        voffA[i] = (unsigned)(R * K + C) * 2u; voffB[i] = (unsigned)(Rb * K + C) * 2u; }
    const size_t kstep = (size_t)(BK * 2);
    const size_t hstep = (size_t)HALF * K * 2;
    const size_t tstep = 2 * hstep;
    const unsigned ldsw = (unsigned)wid * 1024u;
    const int aoff = lds_byte(wr * 64 + fr, fq * 8), boff = lds_byte(wc * 32 + fr, fq * 8);
#define PG8_SA(b, h) (((b) * 2 + (h)) * HTB)
#define PG8_SB(b, h) ((4 + (b) * 2 + (h)) * HTB)
#define PG8_STAGE(bufoff, gbase, voff) do { _Pragma("unroll") for (int _i = 0; _i < 2; ++_i) \
        __builtin_amdgcn_global_load_lds((const unsigned*)((const char*)(gbase) + (voff)[_i]), (PG8_LAS unsigned*)(lds + (bufoff) + ldsw + _i * 8192), 16, 0, 0); } while (0)
#define PG8_LDA(dst, b, h) do { _Pragma("unroll") for (int m = 0; m < 4; ++m) _Pragma("unroll") for (int k = 0; k < 2; ++k) dst[m][k] = *(const PG8_LAS bf16x8*)(lds + PG8_SA(b, h) + aoff + m * 2048 + k * 1024); } while (0)
#define PG8_LDB(dst, b, h) do { _Pragma("unroll") for (int n = 0; n < 2; ++n) _Pragma("unroll") for (int k = 0; k < 2; ++k) dst[n][k] = *(const PG8_LAS bf16x8*)(lds + PG8_SB(b, h) + boff + n * 2048 + k * 1024); } while (0)
#define PG8_MMA(ai, bj, At, Bt) do { __builtin_amdgcn_s_setprio(1); _Pragma("unroll") for (int m = 0; m < 4; ++m) _Pragma("unroll") for (int n = 0; n < 2; ++n) _Pragma("unroll") for (int k = 0; k < 2; ++k) \
        acc[ai][bj][m][n] = __builtin_amdgcn_mfma_f32_16x16x32_bf16(Bt[n][k], At[m][k], acc[ai][bj][m][n], 0, 0, 0); __builtin_amdgcn_s_setprio(0); } while (0)
#define PG8_WAIT_V(n) asm volatile("s_waitcnt vmcnt(" #n ")" ::: "memory")
#define PG8_WAIT_L(n) asm volatile("s_waitcnt lgkmcnt(" #n ")" ::: "memory")
#define PG8_BAR __builtin_amdgcn_s_barrier()
#define PG8_SCHED __builtin_amdgcn_sched_barrier(0)
    Unit cur, nxt; int ui = 0;
    if (!S.next(0, cur)) return;
    f32x4 acc[2][2][4][2];
#pragma unroll
    for (int a = 0; a < 2; ++a)
#pragma unroll
        for (int b = 0; b < 2; ++b)
#pragma unroll
            for (int m = 0; m < 4; ++m)
#pragma unroll
                for (int n = 0; n < 2; ++n) acc[a][b][m][n] = (f32x4){0.f, 0.f, 0.f, 0.f};
    bf16x8 At[4][2], B0[2][2], B1[2][2];
    const char* cA = (const char*)g.A + (size_t)cur.pm * tstep; const char* cB = (const char*)g.Bt + (size_t)cur.pn * tstep;
    S.a_ready(cur);
    if constexpr (SP2) {
        PG8_STAGE(PG8_SB(0, 0), cB, voffB); PG8_STAGE(PG8_SB(0, 1), cB + hstep, voffB); PG8_STAGE(PG8_SA(0, 0), cA, voffA); PG8_STAGE(PG8_SA(0, 1), cA + hstep, voffA);
        if (wr == 1) PG8_BAR;
        PG8_WAIT_V(2); PG8_BAR;
        PG8_STAGE(PG8_SB(1, 0), cB + kstep, voffB); PG8_STAGE(PG8_SA(1, 0), cA + kstep, voffA); PG8_STAGE(PG8_SB(1, 1), cB + hstep + kstep, voffB);
        PG8_WAIT_V(6); PG8_BAR;
    } else {
        PG8_STAGE(PG8_SB(0, 0), cB, voffB); PG8_STAGE(PG8_SA(0, 0), cA, voffA); PG8_STAGE(PG8_SB(0, 1), cB + hstep, voffB); PG8_STAGE(PG8_SA(0, 1), cA + hstep, voffA);
        if (wr == 1) PG8_BAR;
        PG8_WAIT_V(4); PG8_BAR;
        PG8_STAGE(PG8_SB(1, 0), cB + kstep, voffB); PG8_STAGE(PG8_SA(1, 0), cA + kstep, voffA); PG8_STAGE(PG8_SB(1, 1), cB + hstep + kstep, voffB);
        PG8_WAIT_V(6); PG8_BAR;
    }
    for (;;) {
        const bool has_next = S.next(ui + 1, nxt);
        const char* nA = has_next ? (const char*)g.A + (size_t)nxt.pm * tstep : cA; const char* nB = has_next ? (const char*)g.Bt + (size_t)nxt.pn * tstep : cB;
        for (int t = 0; t < nt; t += 2) {
            const bool last = (t == nt - 2);
            const char* a1 = cA + (size_t)(t + 1) * kstep;
            const char* a2 = last ? nA : cA + (size_t)(t + 2) * kstep; const char* b2 = last ? nB : cB + (size_t)(t + 2) * kstep;
            const char* a3 = a2 + kstep; const char* b3 = b2 + kstep;
            if (last && has_next) S.a_ready(nxt);
            if constexpr (SP2) {
            PG8_LDB(B0, 0, 0); PG8_LDB(B1, 0, 1); PG8_SCHED; PG8_LDA(At, 0, 0); PG8_STAGE(PG8_SA(1, 1), a1 + hstep, voffA);
            PG8_WAIT_V(8); PG8_WAIT_L(0); PG8_BAR; PG8_MMA(0, 0, At, B0); PG8_MMA(0, 1, At, B1); PG8_BAR; PG8_SCHED;
            PG8_LDA(At, 0, 1); PG8_STAGE(PG8_SB(0, 0), b2, voffB); PG8_STAGE(PG8_SB(0, 1), b2 + hstep, voffB); PG8_STAGE(PG8_SA(0, 0), a2, voffA);
            PG8_WAIT_V(8); PG8_WAIT_L(0); PG8_BAR; PG8_MMA(1, 0, At, B0); PG8_MMA(1, 1, At, B1); PG8_BAR; PG8_SCHED;
            PG8_LDB(B0, 1, 0); PG8_LDB(B1, 1, 1); PG8_SCHED; PG8_LDA(At, 1, 0); PG8_STAGE(PG8_SA(0, 1), a2 + hstep, voffA);
            PG8_WAIT_V(8); PG8_WAIT_L(0); PG8_BAR; PG8_MMA(0, 0, At, B0); PG8_MMA(0, 1, At, B1); PG8_BAR; PG8_SCHED;
            PG8_LDA(At, 1, 1); PG8_STAGE(PG8_SB(1, 0), b3, voffB); PG8_STAGE(PG8_SB(1, 1), b3 + hstep, voffB); PG8_STAGE(PG8_SA(1, 0), a3, voffA);
            PG8_WAIT_V(8); PG8_WAIT_L(0); PG8_BAR; PG8_MMA(1, 0, At, B0); PG8_MMA(1, 1, At, B1); PG8_BAR; PG8_SCHED;
            } else {
            PG8_LDB(B0, 0, 0); PG8_SCHED; PG8_LDA(At, 0, 0); PG8_STAGE(PG8_SA(1, 1), a1 + hstep, voffA);
            PG8_WAIT_L(8); PG8_BAR; PG8_WAIT_L(0); PG8_MMA(0, 0, At, B0); PG8_BAR; PG8_SCHED;
            PG8_LDB(B1, 0, 1); PG8_STAGE(PG8_SB(0, 0), b2, voffB);
            PG8_BAR; PG8_WAIT_L(0); PG8_MMA(0, 1, At, B1); PG8_BAR;
            PG8_LDA(At, 0, 1); PG8_STAGE(PG8_SA(0, 0), a2, voffA);
            PG8_BAR; PG8_WAIT_L(0); PG8_MMA(1, 0, At, B0); PG8_BAR; PG8_SCHED;
            PG8_STAGE(PG8_SB(0, 1), b2 + hstep, voffB);
            PG8_WAIT_V(6); PG8_BAR; PG8_MMA(1, 1, At, B1); PG8_BAR;
            PG8_LDB(B0, 1, 0); PG8_SCHED; PG8_LDA(At, 1, 0); PG8_STAGE(PG8_SA(0, 1), a2 + hstep, voffA);
            PG8_WAIT_L(8); PG8_BAR; PG8_WAIT_L(0); PG8_MMA(0, 0, At, B0); PG8_BAR; PG8_SCHED;
            PG8_LDB(B1, 1, 1); PG8_STAGE(PG8_SB(1, 0), b3, voffB);
            PG8_BAR; PG8_WAIT_L(0); PG8_MMA(0, 1, At, B1); PG8_BAR;
            PG8_LDA(At, 1, 1); PG8_STAGE(PG8_SA(1, 0), a3, voffA);
            PG8_BAR; PG8_WAIT_L(0); PG8_MMA(1, 0, At, B0); PG8_BAR; PG8_SCHED;
            PG8_STAGE(PG8_SB(1, 1), b3 + hstep, voffB);
            PG8_WAIT_V(6); PG8_BAR; PG8_MMA(1, 1, At, B1); PG8_BAR;
            }
        }
        if constexpr (ALIGN_EPI) { if (wr == 0) PG8_BAR; }
        if constexpr (!Epi::AFTER_DRAIN) { E(acc, cur, wr, wc, fr, fq); S.done(cur); }
        if (!has_next) break;
#pragma unroll
        for (int a = 0; a < 2; ++a)
#pragma unroll
            for (int b = 0; b < 2; ++b)
#pragma unroll
                for (int m = 0; m < 4; ++m)
#pragma unroll
                    for (int n = 0; n < 2; ++n) acc[a][b][m][n] = (f32x4){0.f, 0.f, 0.f, 0.f};
        cur = nxt; cA = nA; cB = nB; ++ui;
        if constexpr (ALIGN_EPI) { if (wr == 1) PG8_BAR; }
    }
    PG8_WAIT_V(0);
    if constexpr (!ALIGN_EPI) { if (wr == 0) PG8_BAR; }
    PG8_BAR;
    if constexpr (Epi::AFTER_DRAIN) { E.fused(acc, cur, wr, wc, fr, fq, lds, wid, lane); S.done(cur); }
#undef PG8_SA
#undef PG8_SB
#undef PG8_STAGE
#undef PG8_LDA
#undef PG8_LDB
#undef PG8_MMA
#undef PG8_WAIT_V
#undef PG8_WAIT_L
#undef PG8_BAR
#undef PG8_SCHED
}
}
namespace att {
#define ALAS __attribute__((address_space(3)))
#define AGAS __attribute__((address_space(1)))
typedef unsigned short bf16;
typedef short bf16x8 __attribute__((ext_vector_type(8)));
typedef short s16x4 __attribute__((ext_vector_type(4)));
typedef short v4i16_t __attribute__((ext_vector_type(4)));
typedef float f32x16 __attribute__((ext_vector_type(16)));
typedef float f32x4 __attribute__((ext_vector_type(4)));
typedef unsigned u32x4 __attribute__((ext_vector_type(4)));
constexpr int SEQ = 16384;
constexpr float THR = 8.f;
#ifndef ATT_PFV
#define ATT_PFV 1
#endif
__device__ __forceinline__ int crow(int r, int hi) { return (r & 3) + 8 * (r >> 2) + 4 * hi; }
typedef float f32x2_t __attribute__((ext_vector_type(2))); typedef __bf16 bf16x2_t __attribute__((ext_vector_type(2)));
__device__ __forceinline__ unsigned cvtpk(float lo, float hi) { f32x2_t v = {lo, hi}; bf16x2_t b = __builtin_convertvector(v, bf16x2_t); return __builtin_bit_cast(unsigned, b); }
__device__ __forceinline__ float bf2f(short v) { return __uint_as_float(((unsigned)(unsigned short)v) << 16); }
__device__ __forceinline__ s16x4 vtr(const ALAS char* p) { return __builtin_bit_cast(s16x4, __builtin_amdgcn_ds_read_tr16_b64_v4i16((ALAS v4i16_t*)p)); }
__device__ __forceinline__ float hmax(float m) { auto rr = __builtin_amdgcn_permlane32_swap(__float_as_uint(m), __float_as_uint(m), false, false); return fmaxf(__uint_as_float(rr[0]), __uint_as_float(rr[1])); }
__device__ __forceinline__ float hsum(float m) { auto rr = __builtin_amdgcn_permlane32_swap(__float_as_uint(m), __float_as_uint(m), false, false); return __uint_as_float(rr[0]) + __uint_as_float(rr[1]); }
__device__ __forceinline__ float max3(float a, float b, float c) { return fmaxf(fmaxf(a, b), c); }
__device__ __forceinline__ float tilemax(const f32x16& p0, const f32x16& p1) {
    float a = max3(p0[0], p0[1], p1[0]), b = max3(p0[2], p0[3], p1[1]); a = max3(a, p1[2], p1[3]);
#pragma unroll
    for (int r = 4; r < 16; r += 4) { a = max3(a, p0[r], p0[r + 1]); b = max3(b, p0[r + 2], p0[r + 3]); a = max3(a, p1[r], p1[r + 1]); b = max3(b, p1[r + 2], p1[r + 3]); }
    return hmax(fmaxf(a, b));
}
__device__ __forceinline__ void cmask(f32x16& p0, f32x16& p1, int jb, int qrel, int hi) {
    const int kbase = 64 * jb + 4 * hi;
#pragma unroll
    for (int r = 0; r < 16; ++r) { const int kv = kbase + (r & 3) + 8 * (r >> 2); if (kv > qrel) p0[r] = -INFINITY; if (kv + 32 > qrel) p1[r] = -INFINITY; }
}
#define ATT_MFMA(a, b, c) __builtin_amdgcn_mfma_f32_32x32x16_bf16(a, b, c, 0, 0, 0)
#define ATT_SGBAR(mask, n) __builtin_amdgcn_sched_group_barrier(mask, n, 0)

template <bool MLA> struct Cfg { static constexpr int NK = MLA ? 6 : 4, KT = MLA ? 12288 : 8192, VT = 8192, STG = 2 * KT + 2 * VT + 512, L_WS = 2 * STG, L_END = L_WS + 2048; };

template <bool MLA, bool FASTREF = false>
__device__ __forceinline__ void attn_unit(int h, int qb, bool rev, const AGAS bf16* Q, const AGAS bf16* __restrict__ Kn, const AGAS bf16* __restrict__ Kr, const AGAS bf16* __restrict__ V, AGAS bf16* O,
                                          const AGAS float* __restrict__ cbg, const AGAS float* __restrict__ cs, ALAS char* shm) {
    typedef Cfg<MLA> C;
    constexpr int QP = MLA ? 1536 : 1024, QH = MLA ? 96 : 64, NK = C::NK, KT = C::KT, VT = C::VT, STG = C::STG;
    int tid_o = threadIdx.x; asm volatile("" : "+v"(tid_o)); const int tid = tid_o, lane = tid & 63, r32 = lane & 31, hi = lane >> 5; const int wid = __builtin_amdgcn_readfirstlane(tid >> 6);
    const int q0 = qb * 256, NI_all = 2 * (qb + 1);
    const AGAS float* cbu = cbg + (size_t)h * SEQ;
    float cbreg = 0.f; float mu = 0.f; (void)cbreg; (void)mu;
    if constexpr (FASTREF) mu = __uint_as_float(__builtin_amdgcn_readfirstlane(__float_as_uint(cbu[q0 + 255] + sqrtf(cs[h] * cs[16 + h]) * 1.02f + 0.25f)));
    ALAS char* kdst = shm + wid * 1024;
    ALAS char* vdst = shm + 2 * KT + wid * 1024;
    ALAS char* krdst = shm + (wid >> 2) * KT + (8 + (wid & 3)) * 1024;
    ALAS char* cbdst = shm + 2 * KT + 2 * VT + (wid & 1) * 256;
#define ATT_GL16(src_, dst_) __builtin_amdgcn_global_load_lds((const AGAS unsigned*)(src_), (ALAS unsigned*)(dst_), 16, 0, 0)
#define ATT_DMA(it_, s_) do { const size_t ko_ = (size_t)(it_) * 128 * 1024; const int so_ = (s_) * STG; \
        int ln_ = __builtin_amdgcn_mbcnt_hi(~0u, __builtin_amdgcn_mbcnt_lo(~0u, 0u)); asm volatile("" : "+v"(ln_)); \
        const AGAS bf16* ks_ = Kn + ko_ + ((unsigned)ln_ * 1024u + (unsigned)(h * 64 + wid * 8)); \
        const AGAS bf16* vs_ = V + ko_ + ((unsigned)(16 * (wid & 3) + (ln_ >> 2)) * 1024u + (unsigned)(h * 64 + (wid >> 2) * 32 + (ln_ & 3) * 8)); \
        ATT_GL16(ks_, kdst + so_); ATT_GL16(ks_ + 64 * 1024, kdst + so_ + KT); ATT_GL16(vs_, vdst + so_); ATT_GL16(vs_ + 64 * 1024, vdst + so_ + VT); \
        if constexpr (MLA) ATT_GL16(Kr + (size_t)(it_) * 128 * 32 + ((unsigned)(64 * (wid >> 2) + ln_) * 32u + (unsigned)((wid & 3) * 8)), krdst + so_); \
        else if constexpr (!FASTREF) { if (wid < 2) __builtin_amdgcn_global_load_lds((const AGAS unsigned*)(cbu + (size_t)(it_) * 128 + ((wid & 1) * 64 + ln_)), (ALAS unsigned*)(cbdst + so_), 4, 0, 0); } \
        else { if (wid < 2) cbreg = cbu[(size_t)(it_) * 128 + ((wid & 1) * 64 + ln_)]; } } while (0)
#define ATT_CBSTORE(s_) do { if constexpr (FASTREF) { if (wid < 2) { int ln_ = __builtin_amdgcn_mbcnt_hi(~0u, __builtin_amdgcn_mbcnt_lo(~0u, 0u)); asm volatile("" : "+v"(ln_)); \
        *(ALAS float*)(cbdst + (s_) * STG + 4 * ln_) = cbreg - mu; } } } while (0)
#define ATT_SYNC() do { asm volatile("s_waitcnt vmcnt(0)" ::: "memory"); __syncthreads(); } while (0)
    const bool dma_early = MLA || rev;
    if (dma_early) ATT_DMA(rev ? NI_all - 1 : 0, 0);
    const AGAS bf16* Qw = Q + (size_t)(q0 + wid * 32 + r32) * QP + h * QH;
    bf16x8 qr[NK];
#pragma unroll
    for (int d0 = 0; d0 < NK; ++d0) qr[d0] = *(const AGAS bf16x8*)(Qw + d0 * 16 + hi * 8);
    if constexpr (MLA) {
        const AGAS float* cp = cs + (size_t)(q0 + wid * 32 + r32) * 32 + hi * 8;
        const f32x4 c0 = *(const AGAS f32x4*)cp, c1 = *(const AGAS f32x4*)(cp + 4), s0 = *(const AGAS f32x4*)(cp + 16), s1 = *(const AGAS f32x4*)(cp + 20);
        bf16x8 a = qr[4], b = qr[5]; unsigned oa[4], ob[4];
#pragma unroll
        for (int j = 0; j < 8; j += 2) {
            const float x1a = bf2f(a[j]), x2a = bf2f(b[j]), x1b = bf2f(a[j + 1]), x2b = bf2f(b[j + 1]);
            const float ca = j < 4 ? c0[j] : c1[j - 4], cb_ = j < 4 ? c0[j + 1] : c1[j - 3], sa = j < 4 ? s0[j] : s1[j - 4], sb = j < 4 ? s0[j + 1] : s1[j - 3];
            oa[j / 2] = cvtpk(x1a * ca - x2a * sa, x1b * cb_ - x2b * sb);
            ob[j / 2] = cvtpk(x1a * sa + x2a * ca, x1b * sb + x2b * cb_);
        }
        qr[4] = __builtin_bit_cast(bf16x8, (u32x4){oa[0], oa[1], oa[2], oa[3]});
        qr[5] = __builtin_bit_cast(bf16x8, (u32x4){ob[0], ob[1], ob[2], ob[3]});
    }
    int it0 = 0;
    if constexpr (!MLA) {
        const AGAS float* cbu_s = cbg + (size_t)h * SEQ;
        const float thr = __uint_as_float(__builtin_amdgcn_readfirstlane(__float_as_uint(cbg[(size_t)h * SEQ + q0 + (FASTREF ? 255 : 0)] - 150.0f)));
        const int ntile = 2 * NI_all;
        const int j1 = 4 * lane + 3; const float v1 = j1 < ntile ? cbu_s[64 * j1 + 63] : 3.0e38f;
        const int g = __builtin_ctzll(__ballot(v1 >= thr));
        const int j2 = 4 * g + (lane & 3); const float v2 = j2 < ntile ? cbu_s[64 * j2 + 63] : 3.0e38f;
        const int lo = 4 * g + __builtin_ctzll(__ballot(v2 >= thr) | 8ull);
        it0 = __builtin_amdgcn_readfirstlane(lo >> 1);
        if (it0 > NI_all - 2) it0 = NI_all - 2;
    }
    const int NI = NI_all;
    if (!dma_early) ATT_DMA(it0, 0);
    ATT_CBSTORE(0);
    ATT_SYNC();
    ALAS float* wsf = (ALAS float*)(shm + C::L_WS) + wid * 64;
    const ALAS char* kb0 = shm + hi * 1024 + r32 * 16;
    const ALAS char* vp0 = shm + 2 * KT + ((lane >> 4) & 1) * 32 + (lane & 3) * 8 + (4 * hi + ((lane & 15) >> 2)) * 64;
    const ALAS float* cb0 = (const ALAS float*)(shm + 2 * KT + 2 * VT) + 4 * hi;
    float mhat = -3.0e38f, l_reg = 0.f; f32x16 o0 = f32x16{}, o1 = f32x16{};
    if constexpr (!MLA && !FASTREF) {
        float qn = 0.f;
#pragma unroll
        for (int d0 = 0; d0 < NK; ++d0)
#pragma unroll
            for (int j = 0; j < 8; ++j) { const float qv = bf2f(qr[d0][j]); qn += qv * qv; }
        qn = hsum(qn);
        mhat = cbg[(size_t)h * SEQ + q0 + wid * 32 + r32] + sqrtf(qn * cs[16 + h]) * 1.02f + 0.25f;
    }
    f32x16 negm = f32x16{};
    if constexpr (MLA) {
        float qn = 0.f;
#pragma unroll
        for (int d0 = 0; d0 < NK; ++d0)
#pragma unroll
            for (int j = 0; j < 8; ++j) { const float qv = bf2f(qr[d0][j]); qn += qv * qv; }
        qn = hsum(qn);
        const float k2 = cbg[2 * h] + cbg[2 * h + 1] + cbg[32];
        mhat = sqrtf(qn * k2) * 1.02f + 0.25f;
#pragma unroll
        for (int r = 0; r < 16; ++r) negm[r] = -mhat;
        asm volatile("" : "+v"(negm));
    }
    const int qrel = wid * 32 + r32;

#define ATT_LOADK(KF, P0, P1, s_, j_) do { const ALAS char* kb_ = kb0 + (s_) * STG + (j_) * KT; \
        _Pragma("unroll") for (int d0 = 0; d0 < NK; ++d0) { KF[2 * d0] = *(const ALAS bf16x8*)(kb_ + d0 * 2048); KF[2 * d0 + 1] = *(const ALAS bf16x8*)(kb_ + d0 * 2048 + 512); } \
        if constexpr (!MLA) { const ALAS float* cbt_ = cb0 + (s_) * (STG / 4) + 64 * (j_); \
            _Pragma("unroll") for (int g = 0; g < 4; ++g) { const f32x4 ca_ = *(const ALAS f32x4*)(cbt_ + 8 * g), cb2_ = *(const ALAS f32x4*)(cbt_ + 32 + 8 * g); \
                _Pragma("unroll") for (int i = 0; i < 4; ++i) { P0[4 * g + i] = ca_[i]; P1[4 * g + i] = cb2_[i]; } } } \
        else { P0 = negm; P1 = negm; } } while (0)
#define ATT_MMAQK(P0, P1, KF) do { _Pragma("unroll") for (int d0 = 0; d0 < NK; ++d0) { P0 = ATT_MFMA(KF[2 * d0], qr[d0], P0); P1 = ATT_MFMA(KF[2 * d0 + 1], qr[d0], P1); } } while (0)
#define ATT_DECIDE(P0, P1, need_) do { const float rm_ = tilemax(P0, P1); need_ = __any(rm_ > mhat + THR); \
        if (need_) { const float mn_ = fmaxf(mhat, rm_); const float f_ = __builtin_amdgcn_exp2f(mhat - mn_); mhat = mn_; l_reg *= f_; if (hi == 0) wsf[r32] = f_; } } while (0)
#define ATT_ORESC() do { _Pragma("unroll") for (int g = 0; g < 4; ++g) { const f32x4 fv_ = *(const ALAS f32x4*)(wsf + 8 * g + 4 * hi); \
        _Pragma("unroll") for (int i = 0; i < 4; ++i) { o0[4 * g + i] *= fv_[i]; o1[4 * g + i] *= fv_[i]; } } } while (0)
#define ATT_EXP(P0, P1, PA) do { float sa_ = 0.f, sb_ = 0.f; \
        _Pragma("unroll") for (int r = 0; r < 16; ++r) { if constexpr (MLA || FASTREF) { P0[r] = __builtin_amdgcn_exp2f(P0[r]); P1[r] = __builtin_amdgcn_exp2f(P1[r]); } else { P0[r] = __builtin_amdgcn_exp2f(P0[r] - mhat); P1[r] = __builtin_amdgcn_exp2f(P1[r] - mhat); } sa_ += P0[r]; asm("" : "+v"(sa_)); sb_ += P1[r]; asm("" : "+v"(sb_)); } \
        l_reg += sa_ + sb_; \
        PA[0] = __builtin_bit_cast(bf16x8, (u32x4){cvtpk(P0[0], P0[1]), cvtpk(P0[2], P0[3]), cvtpk(P0[4], P0[5]), cvtpk(P0[6], P0[7])}); \
        PA[1] = __builtin_bit_cast(bf16x8, (u32x4){cvtpk(P0[8], P0[9]), cvtpk(P0[10], P0[11]), cvtpk(P0[12], P0[13]), cvtpk(P0[14], P0[15])}); \
        PA[2] = __builtin_bit_cast(bf16x8, (u32x4){cvtpk(P1[0], P1[1]), cvtpk(P1[2], P1[3]), cvtpk(P1[4], P1[5]), cvtpk(P1[6], P1[7])}); \
        PA[3] = __builtin_bit_cast(bf16x8, (u32x4){cvtpk(P1[8], P1[9]), cvtpk(P1[10], P1[11]), cvtpk(P1[12], P1[13]), cvtpk(P1[14], P1[15])}); } while (0)
#define ATT_VF(vp_, d0, ks) ({ const s16x4 lo_ = vtr(vp_ + (d0) * 4096 + (ks) * 1024), hi_ = vtr(vp_ + (d0) * 4096 + (ks) * 1024 + 512); (bf16x8){lo_[0], lo_[1], lo_[2], lo_[3], hi_[0], hi_[1], hi_[2], hi_[3]}; })
#define ATT_LOADV(VF, s_, j_) do { const ALAS char* vp_ = vp0 + (s_) * STG + (j_) * VT; \
        _Pragma("unroll") for (int ks = 0; ks < 4; ++ks) { VF[2 * ks] = ATT_VF(vp_, 0, ks); VF[2 * ks + 1] = ATT_VF(vp_, 1, ks); } } while (0)
#define ATT_MMAPV(PA, VF) do { _Pragma("unroll") for (int ks = 0; ks < 4; ++ks) { o0 = ATT_MFMA(PA[ks], VF[2 * ks], o0); o1 = ATT_MFMA(PA[ks], VF[2 * ks + 1], o1); } } while (0)
#define ATT_INTERVAL(s_, BAND_, ib_) do { \
        f32x16 a0, a1, b0, b1; bf16x8 pa[4], pb[4], kfA[2 * NK], kfB[2 * NK], vfA[8], vfB[8]; \
        int ln_ = __builtin_amdgcn_mbcnt_hi(~0u, __builtin_amdgcn_mbcnt_lo(~0u, 0u)); asm volatile("" : "+v"(ln_));     \
        const int hi = ln_ >> 5, r32 = ln_ & 31; const int qrel = wid * 32 + r32; (void)qrel; \
        const ALAS char* kb0 = shm + hi * 1024 + r32 * 16; \
        const ALAS char* vp0 = shm + 2 * KT + ((ln_ >> 4) & 1) * 32 + (ln_ & 3) * 8 + (4 * hi + ((ln_ & 15) >> 2)) * 64; \
        const ALAS float* cb0 = (const ALAS float*)(shm + 2 * KT + 2 * VT) + 4 * hi; (void)cb0; \
          \
        __builtin_amdgcn_sched_barrier(0); \
        ATT_LOADK(kfA, a0, a1, s_, 0); \
        ATT_LOADK(kfB, b0, b1, s_, 1); \
        __builtin_amdgcn_sched_barrier(0); \
        ATT_MMAQK(a0, a1, kfA); \
        ATT_MMAQK(b0, b1, kfB); \
        __builtin_amdgcn_sched_barrier(0); \
        if (BAND_) { cmask(a0, a1, 2 * (ib_), qrel, hi); cmask(b0, b1, 2 * (ib_) + 1, qrel, hi); } \
        ATT_LOADV(vfA, s_, 0); \
        ATT_LOADV(vfB, s_, 1); \
        __builtin_amdgcn_sched_barrier(0); \
        ATT_EXP(a0, a1, pa); \
        ATT_EXP(b0, b1, pb); \
        asm volatile("" : "+v"(pa[0]), "+v"(pa[1]), "+v"(pa[2]), "+v"(pa[3]), "+v"(pb[0]), "+v"(pb[1]), "+v"(pb[2]), "+v"(pb[3]), "+v"(l_reg)); \
        __builtin_amdgcn_sched_barrier(0); \
        ATT_MMAPV(pa, vfA); \
        ATT_MMAPV(pb, vfB); \
        __builtin_amdgcn_sched_barrier(0); \
    } while (0)

    const int nint = NI - it0;
    for (int k = 0; k < nint; ++k) {
        const int it = rev ? NI - 1 - k : it0 + k, itn = rev ? it - 1 : it + 1, cur = k & 1, ib = it - (NI - 2);
        if (k + 1 < nint) ATT_DMA(itn, cur ^ 1);
        if (ib < 0) { if (cur == 0) ATT_INTERVAL(0, false, 0); else ATT_INTERVAL(1, false, 0); }
        else if (ib == 0 || wid >= 4) { if (cur == 0) ATT_INTERVAL(0, true, ib); else ATT_INTERVAL(1, true, ib); }
        if (k + 1 < nint) ATT_CBSTORE(cur ^ 1);
        ATT_SYNC();
    }
    l_reg = hsum(l_reg);
    if (hi == 0) wsf[32 + r32] = l_reg;
    float rli[16];
#pragma unroll
    for (int g = 0; g < 4; ++g) { const f32x4 lv = *(const ALAS f32x4*)(wsf + 32 + 8 * g + 4 * hi);
#pragma unroll
        for (int i = 0; i < 4; ++i) rli[4 * g + i] = __builtin_amdgcn_rcpf(lv[i]); }
    AGAS bf16* Ow = O + (size_t)(q0 + wid * 32) * 1024 + h * 64;
    ALAS bf16* stg = (ALAS bf16*)shm + wid * 2048;
#pragma unroll
    for (int r = 0; r < 16; ++r) { const int orow = crow(r, hi);
        stg[orow * 64 + r32] = (bf16)(cvtpk(o0[r] * rli[r], 0.f) & 0xffffu);
        stg[orow * 64 + 32 + r32] = (bf16)(cvtpk(o1[r] * rli[r], 0.f) & 0xffffu); }
#pragma unroll
    for (int i = 0; i < 4; ++i) { const int row = i * 8 + (lane >> 3), ch = lane & 7; const u32x4 v = *(const ALAS u32x4*)(stg + row * 64 + ch * 8); *(AGAS u32x4*)(Ow + (size_t)row * 1024 + ch * 8) = v; }
    __syncthreads();
#undef ATT_GL16
#undef ATT_DMA
#undef ATT_CBSTORE
#undef ATT_SYNC
#undef ATT_LOADK
#undef ATT_MMAQK
#undef ATT_LOADV
#undef ATT_MMAPV
#undef ATT_DECIDE
#undef ATT_ORESC
#undef ATT_EXP
#undef ATT_VF
#undef ATT_INTERVAL
}
#undef ALAS
#undef AGAS
}
#define GAS __attribute__((address_space(1)))
#define LAS __attribute__((address_space(3)))
typedef unsigned short bf16;
typedef unsigned v4u __attribute__((ext_vector_type(4)));
typedef unsigned v2u __attribute__((ext_vector_type(2)));
typedef float f32x4 __attribute__((ext_vector_type(4)));
#define XB_TMO      128
#define XB_XCNT(j)  (256  + 64 * (j))
#define XB_XSUB(j)  (1280 + 64 * (j))
#define XB_XGEN(j)  (2304 + 64 * (j))
#define XB_TOP      3328
#define XB_TOPGEN   3392
#define XCD_BAR_WORDS 3456
#define XB_SPIN_CAP (1u << 18)

__device__ __forceinline__ unsigned xb_ld(unsigned* p)              { return __hip_atomic_load(p, __ATOMIC_RELAXED, __HIP_MEMORY_SCOPE_AGENT); }
__device__ __forceinline__ unsigned xb_add(unsigned* p, unsigned v) { return __hip_atomic_fetch_add(p, v, __ATOMIC_RELAXED, __HIP_MEMORY_SCOPE_AGENT); }
__device__ __forceinline__ unsigned xb_xcc_id() { return (unsigned)__builtin_amdgcn_s_getreg((3 << 11) | 20) & 0xFu; }
#define XB_SPIN(cond, bar) do { unsigned _sp = 0; while (cond) { __builtin_amdgcn_s_sleep(1); \
    if ((++_sp & 255u) == 0u) { if (xb_ld(&(bar)[XB_TMO])) break; if (_sp > XB_SPIN_CAP) { atomicAdd(&(bar)[XB_TMO], 1u); break; } } } } while (0)

struct XcdBarrier {
    unsigned* bar; unsigned x;
    volatile LAS unsigned* st;
};

__device__ __forceinline__ XcdBarrier xcd_barrier_post(unsigned* bar, volatile LAS unsigned* st) {
    XcdBarrier b; b.bar = bar; b.x = xb_xcc_id(); b.st = st;
    if (threadIdx.x == 0) (void)xb_add(&bar[XB_XCNT(b.x)], 1u);
    return b;
}
__device__ __forceinline__ void xcd_barrier_complete(unsigned* bar, unsigned x, unsigned& nloc, unsigned& nx) {
    const unsigned G = gridDim.x * gridDim.y * gridDim.z;
    unsigned sum, cnt, mine, sp = 0u;
    for (;;) {
        sum = 0u; cnt = 0u; mine = 0u;
#pragma unroll
        for (unsigned j = 0; j < 16; ++j) { const unsigned c = xb_ld(&bar[XB_XCNT(j)]); sum += c; cnt += (c > 0u) ? 1u : 0u; mine = (j == x) ? c : mine; }
        if (sum == G) break;
        __builtin_amdgcn_s_sleep(1);
        if ((++sp & 255u) == 0u) { if (xb_ld(&bar[XB_TMO])) break; if (sp > XB_SPIN_CAP) { atomicAdd(&bar[XB_TMO], 1u); break; } }
    }
    nloc = mine > 0u ? mine : 1u; nx = cnt > 0u ? cnt : 1u;
}

__device__ __forceinline__ void xcd_barrier(const XcdBarrier& b) {
    asm volatile("s_waitcnt vmcnt(0)" ::: "memory");
    __syncthreads();
    if (threadIdx.x == 0) {
        unsigned* bar = b.bar;
        __builtin_amdgcn_s_waitcnt(0);
        unsigned nloc = b.st[0], nx = b.st[1];
        if (nloc == 0u) { xcd_barrier_complete(bar, b.x, nloc, nx); b.st[0] = nloc; b.st[1] = nx; }
        const unsigned old = xb_add(&bar[XB_XSUB(b.x)], 1u);
        const unsigned gen = old / nloc;
        if (old + 1u == (gen + 1u) * nloc) {
            __builtin_amdgcn_fence(__ATOMIC_RELEASE, "agent");
            asm volatile("s_waitcnt vmcnt(0)" ::: "memory");
            const unsigned og = xb_add(&bar[XB_TOP], 1u);
            const unsigned tg = og / nx;
            if (og + 1u == (tg + 1u) * nx) xb_add(&bar[XB_TOPGEN], 1u);
            else XB_SPIN(xb_ld(&bar[XB_TOPGEN]) == tg, bar);
            __builtin_amdgcn_fence(__ATOMIC_ACQUIRE, "agent");
            xb_add(&bar[XB_XGEN(b.x)], 1u);
            asm volatile("s_waitcnt vmcnt(0)" ::: "memory");
        } else {
            XB_SPIN(xb_ld(&bar[XB_XGEN(b.x)]) == gen, bar);
            __builtin_amdgcn_fence(__ATOMIC_ACQUIRE, "agent");
            asm volatile("s_waitcnt vmcnt(0)" ::: "memory");
        }
    }
    __syncthreads();
}
constexpr int SEQ = 16384, DM = 1024, DFF = 2816, NWAVES = 8;
constexpr int LDS_BYTES = 147456;
#ifndef SYNC_REP
#define SYNC_REP 1
#endif
#define GSYNC() do { for (int sr_ = 0; sr_ < SYNC_REP; ++sr_) { XcdBarrier b_; b_.bar = (unsigned*)(ws + WS_CTL); b_.x = xb_xcc_id(); b_.st = (volatile LAS unsigned*)(ldsp + MISC_OFF); xcd_barrier(b_); } } while (0)
#ifndef SCAN_REP
#define SCAN_REP 1
#endif
#ifndef GU_REP
#define GU_REP 1
#endif
#ifndef ATT_REPF
#define ATT_REPF 1
#endif
#ifndef ATT_REPM
#define ATT_REPM 1
#endif
constexpr float RMS_EPS = 1e-6f;
constexpr float LOG2E = 1.4426950408889634f;
constexpr float C2FOX = 0.125f * LOG2E;
constexpr float C2MLA = 0.10206207261596575f * LOG2E;
constexpr size_t MiB = 1u << 20;
constexpr size_t W_GU = 0, W_DN = 11 * MiB, W_O = 16 * MiB + 512 * 1024, W_A = 18 * MiB + 512 * 1024;
constexpr size_t W_DQ = W_A, W_UQ = 20 * MiB, W_KVA = 23 * MiB, W_UKV = 24 * MiB;
constexpr size_t WS_XN = 26 * MiB, WS_BIG = 58 * MiB;
constexpr size_t WS_Q = WS_BIG, WS_K = WS_BIG + 32 * MiB, WS_V = WS_BIG + 64 * MiB;
constexpr size_t WS_HH = WS_BIG;
constexpr size_t WS_CQ = WS_BIG + 48 * MiB, WS_QM = WS_BIG, WS_OM = WS_BIG + 48 * MiB;
constexpr size_t WS_CKV = WS_BIG + 80 * MiB;
constexpr size_t WS_KN = 154 * MiB, WS_VM = 186 * MiB, WS_KR = 218 * MiB, WS_CS = 219 * MiB, WS_LOGF = 221 * MiB, WS_CB = 222 * MiB, WS_CTL = 223 * MiB, WS_SSQH = 224 * MiB, WS_SSQC = 225 * MiB, WS_SSQK = 226 * MiB, WS_END = 227 * MiB;
constexpr int MISC_OFF = LDS_BYTES - 64, CTL_BYTES = 16384, KMAX_OFF = 14336, KMAXF_OFF = 14592;

__device__ __forceinline__ float wave_sum(float v) {
#pragma unroll
    for (int o = 1; o < 64; o <<= 1) v += __shfl_xor(v, o);
    return v;
}
__device__ __forceinline__ unsigned pk2(float lo, float hi) { return pg8::cvt_pk_bf16(lo, hi); }

__device__ __forceinline__ void tr_item(const float* W, int ldw, int Kd, int ncols, bf16* WT, int row_off, int mode, const float* gain, int item, LAS float* scr, int lane) {
    const int nblk = (ncols + 31) >> 5, kb = item / nblk, nb = item - kb * nblk, k0 = 64 * kb, n0 = 32 * nb;
    {
        const int c4 = n0 + 4 * (lane & 7); const bool cv = c4 < ncols; const float* src = W + (size_t)(k0 + (lane >> 3)) * ldw + c4;
#pragma unroll
        for (int i = 0; i < 8; ++i) { const f32x4 v = cv ? *(const f32x4*)(src + (size_t)(8 * i) * ldw) : (f32x4){0.f, 0.f, 0.f, 0.f};
            LAS float* d = scr + ((lane >> 3) + 8 * i) * 33 + 4 * (lane & 7); d[0] = v.x; d[1] = v.y; d[2] = v.z; d[3] = v.w; }
    }
    asm volatile("s_waitcnt lgkmcnt(0)" ::: "memory");
    const int c8 = lane & 7;
    f32x4 ga = (f32x4){1.f, 1.f, 1.f, 1.f}, gb = ga;
    if (gain) { ga = *(const f32x4*)(gain + k0 + 8 * c8); gb = *(const f32x4*)(gain + k0 + 8 * c8 + 4); }
#pragma unroll
    for (int j = 0; j < 4; ++j) { const int nl = (lane >> 3) + 8 * j, n = n0 + nl; const LAS float* s = scr + (8 * c8) * 33 + nl;
        v4u o; o.x = pk2(s[0 * 33] * ga.x, s[1 * 33] * ga.y); o.y = pk2(s[2 * 33] * ga.z, s[3 * 33] * ga.w); o.z = pk2(s[4 * 33] * gb.x, s[5 * 33] * gb.y); o.w = pk2(s[6 * 33] * gb.z, s[7 * 33] * gb.w);
        const int row = mode == 0 ? row_off + n : (256 * (n >> 7) + (n & 127) + (mode == 2 ? 128 : 0));
        if (n < ncols) *(v4u*)(WT + (size_t)row * Kd + k0 + 8 * c8) = o; }
    asm volatile("s_waitcnt lgkmcnt(0)" ::: "memory");
}
__device__ __forceinline__ void conv_job(const float* W, int ldw, int K, int ncols, bf16* WT, int row_off, int mode, const float* gain, int& base, int gw, int NGW, LAS float* scr, int lane) {
    const int nitems = (K >> 6) * ((ncols + 31) >> 5);
    int it = gw - (base % NGW); if (it < 0) it += NGW;
    for (; it < nitems; it += NGW) tr_item(W, ldw, K, ncols, WT, row_off, mode, gain, it, scr, lane);
    base += nitems;
}
template <bool COPY, bool SECOND>
__device__ __forceinline__ void rms1024(const float* xrow, const float* g1, bf16* o1, const float* g2, bf16* o2, float* cpy, int lane) {
    const f32x4* xr = (const f32x4*)xrow + lane; f32x4 v[4]; float s = 0.f;
#pragma unroll
    for (int j = 0; j < 4; ++j) { v[j] = xr[64 * j]; s += (v[j].x * v[j].x + v[j].y * v[j].y) + (v[j].z * v[j].z + v[j].w * v[j].w); }
    if (COPY) {
#pragma unroll
        for (int j = 0; j < 4; ++j) ((f32x4*)cpy + lane)[64 * j] = v[j]; }
    const float inv = 1.0f / sqrtf(wave_sum(s) * (1.f / 1024.f) + RMS_EPS);
#pragma unroll
    for (int j = 0; j < 4; ++j) { const f32x4 g = ((const f32x4*)g1 + lane)[64 * j]; const f32x4 y = v[j] * inv;
        v2u w; w.x = pk2(y.x * g.x, y.y * g.y); w.y = pk2(y.z * g.z, y.w * g.w); ((v2u*)o1 + lane)[64 * j] = w; }
    if (SECOND) {
#pragma unroll
        for (int j = 0; j < 4; ++j) { const f32x4 g = ((const f32x4*)g2 + lane)[64 * j]; const f32x4 y = v[j] * inv;
            v2u w; w.x = pk2(y.x * g.x, y.y * g.y); w.y = pk2(y.z * g.z, y.w * g.w); ((v2u*)o2 + lane)[64 * j] = w; } }
}

typedef const void* cvp_t;
#define ARGP_EARLY(k) (((const __attribute__((address_space(4))) cvp_t*)__builtin_amdgcn_kernarg_segment_ptr())[k])
struct Args { const void* in[20]; float* out; unsigned char* ws; };

__global__ void __launch_bounds__(NWAVES * 64, 2) yoco_fwd(Args a) {
    extern __shared__ __attribute__((aligned(16))) unsigned char lds[];
    cg::grid_group grid = cg::this_grid();
    LAS unsigned char* ldsp = (LAS unsigned char*)lds;
    const int wave = __builtin_amdgcn_readfirstlane((int)threadIdx.x >> 6);
    const int G = gridDim.x, bx = blockIdx.x; const int vcu = (G % 8 == 0) ? (bx % 8) * (G / 8) + bx / 8 : bx;
    const int gw = bx * NWAVES + wave, NGW = G * NWAVES;
    if (threadIdx.x < 16) ((LAS unsigned*)(ldsp + MISC_OFF))[threadIdx.x] = 0u;
    __syncthreads();
    (void)xcd_barrier_post((unsigned*)((unsigned char*)ARGP_EARLY(21) + WS_CTL), (volatile LAS unsigned*)(ldsp + MISC_OFF));
#define LANE_O() ({ int t_ = threadIdx.x; asm volatile("" : "+v"(t_)); t_ & 63; })
#define TID_O() ({ int t_ = threadIdx.x; asm volatile("" : "+v"(t_)); t_; })
#define ARGP(k) ({ const __attribute__((address_space(4))) cvp_t* p_ = (const __attribute__((address_space(4))) cvp_t*)__builtin_amdgcn_kernarg_segment_ptr(); asm volatile("" : "+s"(p_)); p_[k]; })
#define scr ((LAS float*)(ldsp + wave * 16384))
#define in_x ((const float*)ARGP(0))
#define positions ((const int*)ARGP(1))
#define attn_norm ((const float*)ARGP(2))
#define ffn_norm ((const float*)ARGP(3))
#define w_gate ((const float*)ARGP(4))
#define w_up ((const float*)ARGP(5))
#define w_down ((const float*)ARGP(6))
#define fox_w_in ((const float*)ARGP(7))
#define fox_b_f ((const float*)ARGP(8))
#define fox_w_o ((const float*)ARGP(9))
#define kv_norm ((const float*)ARGP(10))
#define w_kv_a ((const float*)ARGP(11))
#define ckv_norm ((const float*)ARGP(12))
#define w_uk ((const float*)ARGP(13))
#define w_uv ((const float*)ARGP(14))
#define mla_w_dq ((const float*)ARGP(15))
#define cq_norm ((const float*)ARGP(16))
#define mla_w_uq ((const float*)ARGP(17))
#define mla_w_o ((const float*)ARGP(18))
#define final_norm ((const float*)ARGP(19))
#define out ((float*)ARGP(20))
#define ws ((unsigned char*)ARGP(21))
#define XN ((bf16*)(ws + WS_XN))
#define logfT ((float*)(ws + WS_LOGF))
#define cbg ((float*)(ws + WS_CB))
#define cst ((float*)(ws + WS_CS))

#define SSQH ((float*)(ws + WS_SSQH))
#define SSQC ((float*)(ws + WS_SSQC))
#define SSQK ((float*)(ws + WS_SSQK))
#define CONV_A(l_, gw_, ngw_) do { const int L_ = (l_); int base_ = 0; const int lane = LANE_O(); \
        if (L_ < 2) { \
            conv_job(fox_w_in + (size_t)L_ * 1024 * 3088, 3088, 1024, 3088, (bf16*)(ws + W_A), 0, 0, attn_norm + L_ * DM, base_, gw_, ngw_, scr, lane); \
        } else { \
            conv_job(mla_w_dq + (size_t)(L_ - 2) * 1024 * 768, 768, 1024, 768, (bf16*)(ws + W_DQ), 0, 0, attn_norm + L_ * DM, base_, gw_, ngw_, scr, lane); \
            conv_job(mla_w_uq + (size_t)(L_ - 2) * 768 * 1536, 1536, 768, 1536, (bf16*)(ws + W_UQ), 0, 0, cq_norm + (L_ - 2) * 768, base_, gw_, ngw_, scr, lane); \
            if (L_ == 2) { \
                conv_job(w_kv_a, 288, 1024, 288, (bf16*)(ws + W_KVA), 0, 0, kv_norm, base_, gw_, ngw_, scr, lane); \
                conv_job(w_uk, 1024, 256, 1024, (bf16*)(ws + W_UKV), 0, 0, ckv_norm, base_, gw_, ngw_, scr, lane); \
                conv_job(w_uv, 1024, 256, 1024, (bf16*)(ws + W_UKV), 1024, 0, ckv_norm, base_, gw_, ngw_, scr, lane); \
            } \
        } } while (0)
#define CONV_REST(l_, gw_, ngw_) do { const int L_ = (l_); int base_ = 0; const int lane = LANE_O(); \
        conv_job((L_ < 2 ? fox_w_o + (size_t)L_ * 1024 * 1024 : mla_w_o + (size_t)(L_ - 2) * 1024 * 1024), 1024, 1024, 1024, (bf16*)(ws + W_O), 0, 0, nullptr, base_, gw_, ngw_, scr, lane); \
        conv_job(w_gate + (size_t)L_ * 1024 * DFF, DFF, 1024, DFF, (bf16*)(ws + W_GU), 0, 1, ffn_norm + L_ * DM, base_, gw_, ngw_, scr, lane); \
        conv_job(w_up + (size_t)L_ * 1024 * DFF, DFF, 1024, DFF, (bf16*)(ws + W_GU), 0, 2, ffn_norm + L_ * DM, base_, gw_, ngw_, scr, lane); \
        conv_job(w_down + (size_t)L_ * DFF * 1024, 1024, DFF, 1024, (bf16*)(ws + W_DN), 0, 0, nullptr, base_, gw_, ngw_, scr, lane); \
    } while (0)
#define RUN_GEMM(EpiT, E_, Ap, Bp, N_, K_) do { pg8::Gemm g_{(const pg8::bf16_t*)(Ap), (const pg8::bf16_t*)(Bp), SEQ, (N_), (K_)}; pg8::StaticOrder S_; \
        int bxo_ = blockIdx.x, go_ = gridDim.x; asm volatile("" : "+s"(bxo_), "+s"(go_));     \
        S_.init(SEQ, (N_), go_, bxo_); \
        pg8::gemm_phase<EpiT, pg8::StaticOrder, true, true>(ldsp, g_, S_, E_); } while (0)

    CONV_A(0, gw, NGW);
    { const int lane = LANE_O();
    for (int idx = gw * 64 + lane; idx < SEQ * 16; idx += NGW * 64) {
        const int s = idx >> 4, i = idx & 15;
        const float inv_freq = powf(10000.0f, -(float)(2 * i) / 32.0f);
        const float ang = (float)positions[s] * inv_freq;
        const double rev = (double)ang * 0.15915494309189535; const float fr = (float)(rev - rint(rev));
        cst[s * 32 + i] = __builtin_amdgcn_cosf(fr); cst[s * 32 + 16 + i] = __builtin_amdgcn_sinf(fr);
    }
    for (int m = gw; m < SEQ; m += NGW) {
        const f32x4* xr = (const f32x4*)(in_x + (size_t)m * DM) + lane; f32x4 v[4]; float s = 0.f;
#pragma unroll
        for (int j = 0; j < 4; ++j) { v[j] = __builtin_nontemporal_load(xr + 64 * j); s += (v[j].x * v[j].x + v[j].y * v[j].y) + (v[j].z * v[j].z + v[j].w * v[j].w); }
#pragma unroll
        for (int j = 0; j < 4; ++j) { v2u w; w.x = pk2(v[j].x, v[j].y); w.y = pk2(v[j].z, v[j].w); ((v2u*)(XN + (size_t)m * DM) + lane)[64 * j] = w; }
        s = wave_sum(s);
        if (lane < 16) SSQH[(size_t)m * 16 + lane] = lane == 0 ? s : 0.f;
    } }
    if (gridDim.x == 0x7fffffffu) grid.sync();
    GSYNC();

#pragma nounroll
    for (int l = 0; l < 4; ++l) {
        const bf16* Optr;
        if (l < 2) {
            { pg8::EpiBf16S E{(pg8::bf16_t*)(ws + WS_Q), 1024, 1024, (size_t)16777216, C2FOX, 1, -1, nullptr, SSQH, 4, 1.f / 1024.f, 0, nullptr};
              RUN_GEMM(pg8::EpiBf16S, E, XN, ws + W_A, 3072, 1024); }
            {
                const int lane = LANE_O(); typedef short fg_bf16x8 __attribute__((ext_vector_type(8))); const float bfv = fox_b_f[l * 16 + (lane & 15)];
                for (int task = gw; task < SEQ / 16; task += NGW) {
                    const int r0 = task * 16;
                    const bf16* ap = XN + (size_t)(r0 + (lane & 15)) * 1024 + 8 * (lane >> 4);
                    const bf16* bp = (const bf16*)(ws + W_A) + (size_t)(3072 + (lane & 15)) * 1024 + 8 * (lane >> 4);
                    f32x4 acc = (f32x4){0.f, 0.f, 0.f, 0.f};
#pragma unroll 8
                    for (int kk = 0; kk < 32; ++kk) { const fg_bf16x8 av = *(const fg_bf16x8*)(ap + kk * 32), bv = *(const fg_bf16x8*)(bp + kk * 32); acc = __builtin_amdgcn_mfma_f32_16x16x32_bf16(av, bv, acc, 0, 0, 0); }
#pragma unroll
                    for (int i = 0; i < 4; ++i) { const int row = r0 + 4 * (lane >> 4) + i; const float xx = acc[i] * pg8::row_inv(SSQH, row, 4, 1.f / 1024.f) + bfv; acc[i] = fminf(xx, 0.f) - __logf(1.f + __expf(-fabsf(xx))); }
                    *(f32x4*)(logfT + (size_t)(lane & 15) * SEQ + r0 + 4 * (lane >> 4)) = acc;
                }
            }
            GSYNC();
            for (int sr2_ = 0; sr2_ < SCAN_REP; ++sr2_) {
            if (bx < 16) {
                const int tid = TID_O(), lane = tid & 63;
                const float* src = logfT + (size_t)bx * SEQ + tid * 32; float v[32]; float run = 0.f;
#pragma unroll
                for (int j = 0; j < 8; ++j) { const f32x4 t4 = *(const f32x4*)(src + 4 * j); run += t4.x; v[4 * j] = run; run += t4.y; v[4 * j + 1] = run; run += t4.z; v[4 * j + 2] = run; run += t4.w; v[4 * j + 3] = run; }
                float inc = run;
#pragma unroll
                for (int o = 1; o < 64; o <<= 1) { const float t = __shfl_up(inc, o); if (lane >= o) inc += t; }
                LAS float* wt = (LAS float*)ldsp;
                if (lane == 63) wt[wave] = inc;
                __syncthreads();
                float off = inc - run;
                for (int w = 0; w < wave; ++w) off += wt[w];
                float* dst = cbg + (size_t)bx * SEQ + tid * 32;
#pragma unroll
                for (int j = 0; j < 8; ++j) *(f32x4*)(dst + 4 * j) = (f32x4){(off + v[4 * j]) * -LOG2E, (off + v[4 * j + 1]) * -LOG2E, (off + v[4 * j + 2]) * -LOG2E, (off + v[4 * j + 3]) * -LOG2E};
                __syncthreads();
            }
            if (bx >= 16 || G <= 16) {
                const int gwc = (G > 16 ? (bx - 16) : bx) * NWAVES + wave, ngwc = (G > 16 ? (G - 16) : G) * NWAVES;
                CONV_REST(l, gwc, ngwc);
                CONV_A(l + 1, gwc, ngwc);
                {
                    const int lane = LANE_O(); float mq = 0.f, mk = 0.f;
                    for (int m0 = gwc * 4; m0 < SEQ; m0 += ngwc * 4) {
                        v4u qv[4][2], kv[4][2];
#pragma unroll
                        for (int r = 0; r < 4; ++r) { const v4u* qp = (const v4u*)((const bf16*)(ws + WS_Q) + (size_t)(m0 + r) * 1024 + lane * 16); const v4u* kp = (const v4u*)((const bf16*)(ws + WS_K) + (size_t)(m0 + r) * 1024 + lane * 16);
                            qv[r][0] = qp[0]; qv[r][1] = qp[1]; kv[r][0] = kp[0]; kv[r][1] = kp[1]; }
#pragma unroll
                        for (int r = 0; r < 4; ++r) { float sq = 0.f, sk = 0.f;
#pragma unroll
                            for (int j = 0; j < 4; ++j) { const float a0 = __uint_as_float(qv[r][0][j] << 16), a1 = __uint_as_float(qv[r][0][j] & 0xffff0000u), a2 = __uint_as_float(qv[r][1][j] << 16), a3 = __uint_as_float(qv[r][1][j] & 0xffff0000u);
                                sq += (a0 * a0 + a1 * a1) + (a2 * a2 + a3 * a3);
                                const float b0 = __uint_as_float(kv[r][0][j] << 16), b1 = __uint_as_float(kv[r][0][j] & 0xffff0000u), b2 = __uint_as_float(kv[r][1][j] << 16), b3 = __uint_as_float(kv[r][1][j] & 0xffff0000u);
                                sk += (b0 * b0 + b1 * b1) + (b2 * b2 + b3 * b3); }
                            sq += __shfl_xor(sq, 1); sq += __shfl_xor(sq, 2); sk += __shfl_xor(sk, 1); sk += __shfl_xor(sk, 2);
                            mq = fmaxf(mq, sq); mk = fmaxf(mk, sk); }
                    }
                    if ((lane & 3) == 0) {
                        unsigned* km = (unsigned*)(ws + WS_CTL + KMAXF_OFF) + l * 64; const unsigned uq = __float_as_uint(mq), uk = __float_as_uint(mk);
                        if (uq > __hip_atomic_load(km + (lane >> 2), __ATOMIC_RELAXED, __HIP_MEMORY_SCOPE_AGENT)) atomicMax(km + (lane >> 2), uq);
                        if (uk > __hip_atomic_load(km + 16 + (lane >> 2), __ATOMIC_RELAXED, __HIP_MEMORY_SCOPE_AGENT)) atomicMax(km + 16 + (lane >> 2), uk); }
                }
            }
            GSYNC();
            }
            for (int rep_ = 0; rep_ < ATT_REPF; ++rep_)
            for (int i = 0;; ++i) { int hh, qb;
                if (G == 256) { if (i >= 4) break; const int s = vcu & 15; hh = ((vcu >> 4) + 4 * i) & 15; qb = (i == 0) ? 63 - s : (i == 1) ? 32 + s : (i == 2) ? 31 - s : s; }
                else { const int j = vcu + i * G; if (j >= 1024) break; hh = j >> 6; qb = 63 - (j & 63); }
                {
                    const float* nbp = cbg + (size_t)hh * SEQ + qb * 256; const float* kmf = (const float*)(ws + WS_CTL + KMAXF_OFF) + l * 64;
                    const float span = 2.f * (sqrtf(kmf[hh] * kmf[16 + hh]) * 1.02f + 0.25f) + (nbp[255] - nbp[0]);
                    const bool fast = __builtin_amdgcn_readfirstlane((int)(span < 118.f)) != 0;
                    if (fast) att::attn_unit<false, true>(hh, qb, (i & 1) != 0, (const GAS bf16*)(ws + WS_Q), (const GAS bf16*)(ws + WS_K), nullptr, (const GAS bf16*)(ws + WS_V), (GAS bf16*)(ws + WS_KN), (const GAS float*)cbg, (const GAS float*)(ws + WS_CTL + KMAXF_OFF) + l * 64, (LAS char*)ldsp);
                    else att::attn_unit<false, false>(hh, qb, (i & 1) != 0, (const GAS bf16*)(ws + WS_Q), (const GAS bf16*)(ws + WS_K), nullptr, (const GAS bf16*)(ws + WS_V), (GAS bf16*)(ws + WS_KN), (const GAS float*)cbg, (const GAS float*)(ws + WS_CTL + KMAXF_OFF) + l * 64, (LAS char*)ldsp);
                } }
            GSYNC();
            Optr = (const bf16*)(ws + WS_KN);
        } else {
            if (l == 2) {
                pg8::EpiNormOut E{(pg8::bf16_t*)(ws + WS_CKV), 256, SSQH, SSQK, -1, nullptr, nullptr, nullptr};
                pg8::Gemm g_{(const pg8::bf16_t*)XN, (const pg8::bf16_t*)(ws + W_KVA), SEQ, 256, 1024}; pg8::StaticOrder S_;
                int bxo_ = blockIdx.x, go_ = gridDim.x; asm volatile("" : "+s"(bxo_), "+s"(go_));
                S_.init(SEQ, 256, go_, go_ == 256 ? ((bxo_ + 64) & 255) : bxo_);
                pg8::gemm_phase<pg8::EpiNormOut, pg8::StaticOrder, true, true>(ldsp, g_, S_, E);
            }
            { pg8::EpiNormOut E{(pg8::bf16_t*)(ws + WS_CQ), 768, SSQH, SSQC, -1, nullptr, nullptr, nullptr}; RUN_GEMM(pg8::EpiNormOut, E, XN, ws + W_DQ, 768, 1024); }
            if (l == 2) {
                const int lane = LANE_O(); typedef short kr_bf16x8 __attribute__((ext_vector_type(8))); const int n = lane & 15; float mr = 0.f;
                for (int task = gw; task < SEQ / 16; task += NGW) {
                    const int r0 = task * 16;
                    const bf16* ap = XN + (size_t)(r0 + n) * 1024 + 8 * (lane >> 4);
                    const bf16* bp1 = (const bf16*)(ws + W_KVA) + (size_t)(256 + n) * 1024 + 8 * (lane >> 4); const bf16* bp2 = bp1 + 16 * 1024;
                    f32x4 acc1 = (f32x4){0.f, 0.f, 0.f, 0.f}, acc2 = acc1;
#pragma unroll 8
                    for (int kk = 0; kk < 32; ++kk) { const kr_bf16x8 av = *(const kr_bf16x8*)(ap + kk * 32), b1 = *(const kr_bf16x8*)(bp1 + kk * 32), b2 = *(const kr_bf16x8*)(bp2 + kk * 32);
                        acc1 = __builtin_amdgcn_mfma_f32_16x16x32_bf16(av, b1, acc1, 0, 0, 0); acc2 = __builtin_amdgcn_mfma_f32_16x16x32_bf16(av, b2, acc2, 0, 0, 0); }
#pragma unroll
                    for (int i = 0; i < 4; ++i) { const int row = r0 + 4 * (lane >> 4) + i; const float rs = pg8::row_inv(SSQH, row, 4, 1.f / 1024.f);
                        const float x1 = acc1[i] * rs, x2 = acc2[i] * rs, c = cst[(size_t)row * 32 + n], s = cst[(size_t)row * 32 + 16 + n];
                        const float o1 = x1 * c - x2 * s, o2 = x1 * s + x2 * c;
                        bf16* kr = (bf16*)(ws + WS_KR) + (size_t)row * 32;
                        kr[n] = (bf16)(pk2(o1, 0.f) & 0xffffu); kr[16 + n] = (bf16)(pk2(o2, 0.f) & 0xffffu);
                        float sr = o1 * o1 + o2 * o2; sr += __shfl_xor(sr, 1); sr += __shfl_xor(sr, 2); sr += __shfl_xor(sr, 4); sr += __shfl_xor(sr, 8);
                        mr = fmaxf(mr, sr); }
                }
                mr = fmaxf(mr, __shfl_xor(mr, 16)); mr = fmaxf(mr, __shfl_xor(mr, 32));
                if (lane == 0) { unsigned* kp = (unsigned*)(ws + WS_CTL + KMAX_OFF) + 32; const unsigned um = __float_as_uint(mr); if (um > __hip_atomic_load(kp, __ATOMIC_RELAXED, __HIP_MEMORY_SCOPE_AGENT)) atomicMax(kp, um); }
            }
            GSYNC();
            if (l == 2) { pg8::EpiBf16S E{(pg8::bf16_t*)(ws + WS_KN), 1024, 1024, (size_t)16777216, 1.f, 0, -1, nullptr, SSQK, 1, 1.f / 256.f, 0, (unsigned*)(ws + WS_CTL + KMAX_OFF)};
                          RUN_GEMM(pg8::EpiBf16S, E, ws + WS_CKV, ws + W_UKV, 2048, 256); }
            { pg8::EpiBf16S E{(pg8::bf16_t*)(ws + WS_QM), 1536, 0, (size_t)0, C2MLA, 1, -1, nullptr, SSQC, 3, 1.f / 768.f, 0, nullptr};
              RUN_GEMM(pg8::EpiBf16S, E, ws + WS_CQ, ws + W_UQ, 1536, 768); }
            GSYNC();
            CONV_REST(l, gw, NGW);
            if (l < 3) CONV_A(l + 1, gw, NGW);
            __syncthreads();
            for (int rep_ = 0; rep_ < ATT_REPM; ++rep_)
            for (int i = 0;; ++i) { int hh, qb;
                if (G == 256) { if (i >= 4) break; const int s = vcu & 15; hh = vcu >> 4; qb = (i == 0) ? 63 - s : (i == 1) ? 32 + s : (i == 2) ? 31 - s : s; }
                else { const int j = vcu + i * G; if (j >= 1024) break; hh = j >> 6; qb = 63 - (j & 63); }
                att::attn_unit<true>(hh, qb, (i & 1) != 0, (const GAS bf16*)(ws + WS_QM), (const GAS bf16*)(ws + WS_KN), (const GAS bf16*)(ws + WS_KR), (const GAS bf16*)(ws + WS_VM), (GAS bf16*)(ws + WS_OM), (const GAS float*)(ws + WS_CTL + KMAX_OFF), (const GAS float*)cst, (LAS char*)ldsp); }
            GSYNC();
            Optr = (const bf16*)(ws + WS_OM);
        }
        { pg8::EpiResAdd E{(pg8::bf16_t*)XN, SSQH, 1024}; RUN_GEMM(pg8::EpiResAdd, E, Optr, ws + W_O, 1024, 1024); }
        GSYNC();
        for (int rg_ = 0; rg_ < GU_REP; ++rg_) { pg8::EpiSwiGLU E{(pg8::bf16_t*)(ws + WS_HH), DFF, SSQH}; RUN_GEMM(pg8::EpiSwiGLU, E, XN, ws + W_GU, 2 * DFF, 1024); }
        GSYNC();
        { pg8::EpiResAdd E{(pg8::bf16_t*)XN, SSQH, 1024}; RUN_GEMM(pg8::EpiResAdd, E, ws + WS_HH, ws + W_DN, 1024, DFF); }
        GSYNC();
    }
    { const int lane = LANE_O();
    for (int m = gw; m < SEQ; m += NGW) {
        const v2u* hr = (const v2u*)(XN + (size_t)m * DM) + lane; f32x4* xr = (f32x4*)(out + (size_t)m * DM) + lane; f32x4 v[4]; float s = 0.f;
#pragma unroll
        for (int j = 0; j < 4; ++j) { const v2u hw = hr[64 * j]; v[j] = (f32x4){__uint_as_float(hw.x << 16), __uint_as_float(hw.x & 0xffff0000u), __uint_as_float(hw.y << 16), __uint_as_float(hw.y & 0xffff0000u)};
            s += (v[j].x * v[j].x + v[j].y * v[j].y) + (v[j].z * v[j].z + v[j].w * v[j].w); }
        const float inv = 1.0f / sqrtf(wave_sum(s) * (1.f / 1024.f) + RMS_EPS);
#pragma unroll
        for (int j = 0; j < 4; ++j) { const f32x4 g = ((const f32x4*)final_norm + lane)[64 * j]; __builtin_nontemporal_store(v[j] * inv * g, xr + 64 * j); }
    } }
}

#undef in_x
#undef out
#undef ws
#undef scr
#undef positions
extern "C" void kernel_launch(void* const* d_in, const int* in_sizes, int n_in, void* d_out, int out_size, void* d_ws, size_t ws_size, hipStream_t stream) {
    static int grid = 0;
    if (grid == 0) {
        if (n_in != 20 || out_size != SEQ * DM || ws_size < WS_END) { fprintf(stderr, "kernel_launch: unexpected problem shape (n_in %d, out %d, ws %zu)\n", n_in, out_size, ws_size); grid = -1; return; }
        int dev = 0, cus = 0, per_cu = 0;
        if (hipGetDevice(&dev) != hipSuccess || hipDeviceGetAttribute(&cus, hipDeviceAttributeMultiprocessorCount, dev) != hipSuccess) { grid = -1; return; }
        if (hipFuncSetAttribute((const void*)yoco_fwd, hipFuncAttributeMaxDynamicSharedMemorySize, LDS_BYTES) != hipSuccess) { fprintf(stderr, "kernel_launch: hipFuncSetAttribute failed\n"); grid = -1; return; }
        if (hipOccupancyMaxActiveBlocksPerMultiprocessor(&per_cu, (const void*)yoco_fwd, NWAVES * 64, LDS_BYTES) != hipSuccess || per_cu < 1) per_cu = 1;
        (void)hipGetLastError();
        grid = cus * per_cu;
    }
    if (grid < 0) return;
    if (hipMemsetAsync((char*)d_ws + WS_CTL, 0, CTL_BYTES, stream) != hipSuccess) { fprintf(stderr, "kernel_launch: memset failed\n"); return; }
    Args a{};
    for (int i = 0; i < 20; ++i) a.in[i] = d_in[i];
    a.out = (float*)d_out; a.ws = (unsigned char*)d_ws;
    void* params[] = {&a};
    hipError_t e = hipLaunchCooperativeKernel((const void*)yoco_fwd, dim3(grid), dim3(NWAVES * 64), params, LDS_BYTES, stream);
    if (e != hipSuccess) fprintf(stderr, "cooperative launch failed: %s (grid %d)\n", hipGetErrorString(e), grid);
}
```

```cpp
#include <hip/hip_runtime.h>
#include <hip/hip_cooperative_groups.h>
#include <cstdio>
#include <cstdint>
namespace cg = cooperative_groups;
namespace pg8 {
#define PG8_LAS __attribute__((address_space(3)))
typedef unsigned short bf16_t;
typedef short bf16x8 __attribute__((ext_vector_type(8)));
typedef float f32x4 __attribute__((ext_vector_type(4)));
typedef unsigned u32x4 __attribute__((ext_vector_type(4)));
constexpr int BM = 256, BK = 64, HALF = 128, HTB = HALF * BK * 2  , STAGE_BYTES = 8 * HTB, NXCD = 8, WGM = 8;

__host__ __device__ __forceinline__ int lds_byte(int r, int c) { const int st = (r >> 4) * 2 + (c >> 5), rr = r & 15, cc = c & 31, ob = rr * 64 + cc * 2; return st * 1024 + (ob ^ (((ob >> 9) & 1) << 5)); }
__host__ __device__ __forceinline__ void stage_rc(int b, int& R, int& C) { const int st = b / 1024, sb = b % 1024, swz = sb ^ (((sb >> 9) & 1) << 5); R = (st >> 1) * 16 + swz / 64; C = (st & 1) * 32 + (swz % 64) / 2; }
__host__ __device__ __forceinline__ int perm32(int rho) { const int n = rho >> 4, i = rho & 15; return 8 * (i >> 2) + 4 * n + (i & 3); }

struct Unit { int pm, pn; };
struct Gemm { const bf16_t* A; const bf16_t* Bt; int M, N, K; };

struct StaticOrder {
    int nM, nN, nwg, G, c;
    __host__ __device__ void init(int M, int N, int G_, int c_) { nM = M / BM; nN = N / BM; nwg = nM * nN; G = G_; c = c_; }
    __host__ __device__ bool next(int i, Unit& u) const {
        const long L = (long)i * G + c; if (L >= nwg) return false;
        int wgid = (int)L; { const int q = nwg / NXCD, r = nwg % NXCD, xcd = wgid % NXCD, off = wgid / NXCD; wgid = (xcd < r ? xcd * (q + 1) : r * (q + 1) + (xcd - r) * q) + off; }
        const int nig = WGM * nN, gid = wgid / nig, fm = gid * WGM, gsz = (nM - fm) < WGM ? (nM - fm) : WGM;
        u.pm = fm + ((wgid % nig) % gsz); u.pn = (wgid % nig) / gsz; return true;
    }
    __device__ __forceinline__ void a_ready(const Unit&) const {}
    __device__ __forceinline__ void done(const Unit&) const {}
};

__device__ __forceinline__ unsigned cvt_pk_bf16(float lo, float hi) { unsigned r; asm volatile("v_cvt_pk_bf16_f32 %0, %1, %2" : "=v"(r) : "v"(lo), "v"(hi)); return r; }
typedef float f32x2 __attribute__((ext_vector_type(2)));
typedef unsigned u32x2 __attribute__((ext_vector_type(2)));
__device__ __forceinline__ float row_inv(const float* ssq, int row, int nvec, float inv_n) {
    if (!ssq) return 1.f;
    const f32x4* p = (const f32x4*)(ssq + (size_t)row * 16); f32x4 s = p[0];
    if (nvec > 1) s += p[1];
    if (nvec > 2) s += p[2];
    if (nvec > 3) s += p[3];
    return 1.0f / sqrtf(((s.x + s.y) + (s.z + s.w)) * inv_n + 1e-6f);
}
struct EpiBf16S {
    static constexpr bool PERM = true, AFTER_DRAIN = false;
    bf16_t* O; int ldc; int split_cols; size_t split_stride; float scale0; int nscale;
    int fgate_pn; float* logit;
    const float* ssq; int nvec; float inv_n;
    int kmax_tmax; unsigned* kmax;
    __device__ __forceinline__ void operator()(const f32x4 (&acc)[2][2][4][2], const Unit& u, int wr, int wc, int fr, int fq) const {
        const int row0 = u.pm * BM + wr * 64 + fr;
        if (u.pn == fgate_pn) {
            if (wc == 0 && fq < 2) {
#pragma unroll
                for (int ai = 0; ai < 2; ++ai)
#pragma unroll
                    for (int m = 0; m < 4; ++m) { const int row = row0 + ai * HALF + m * 16; const float rs = row_inv(ssq, row, nvec, inv_n); float* lp = logit + (size_t)row * 16 + 8 * fq;
                        *(f32x4*)lp = acc[ai][0][m][0] * rs; *(f32x4*)(lp + 4) = acc[ai][0][m][1] * rs; }
            }
            return;
        }
        int colt = u.pn * BM; bf16_t* base = O; int t = 0;
        if (split_cols) { t = colt / split_cols; base += (size_t)t * split_stride; colt -= t * split_cols; }
        const float sc = (t < nscale) ? scale0 : 1.f;
        const int col0 = colt + wc * 32 + 8 * fq; float mx[2] = {0.f, 0.f};
#pragma unroll
        for (int ai = 0; ai < 2; ++ai)
#pragma unroll
            for (int m = 0; m < 4; ++m) { const int row = row0 + ai * HALF + m * 16; const float rs = row_inv(ssq, row, nvec, inv_n) * sc; bf16_t* rowp = base + (size_t)row * ldc + col0;
#pragma unroll
                for (int bj = 0; bj < 2; ++bj) { f32x4 v0 = acc[ai][bj][m][0] * rs, v1 = acc[ai][bj][m][1] * rs;
                    if (kmax && t <= kmax_tmax) { float sb = ((v0[0] * v0[0] + v0[1] * v0[1]) + (v0[2] * v0[2] + v0[3] * v0[3])) + ((v1[0] * v1[0] + v1[1] * v1[1]) + (v1[2] * v1[2] + v1[3] * v1[3]));
                        sb += __shfl_xor(sb, 16); sb += __shfl_xor(sb, 32); mx[bj] = fmaxf(mx[bj], sb); }
                    u32x4 w; w.x = cvt_pk_bf16(v0[0], v0[1]); w.y = cvt_pk_bf16(v0[2], v0[3]); w.z = cvt_pk_bf16(v1[0], v1[1]); w.w = cvt_pk_bf16(v1[2], v1[3]);
                    *(u32x4*)(rowp + bj * HALF) = w; } }
        if (kmax && t <= kmax_tmax) {
#pragma unroll
            for (int bj = 0; bj < 2; ++bj) { float mm = mx[bj];
#pragma unroll
                for (int o = 1; o < 16; o <<= 1) mm = fmaxf(mm, __shfl_xor(mm, o));
                if (fr == 0 && fq == 0) { unsigned* kp = kmax + (4 * u.pn + 2 * bj + (wc >> 1)) * 2 + (wc & 1); const unsigned um = __float_as_uint(mm);
                    if (um > __hip_atomic_load(kp, __ATOMIC_RELAXED, __HIP_MEMORY_SCOPE_AGENT)) atomicMax(kp, um); } }
        }
    }
};
__device__ __forceinline__ float silu_mul(float g, float u) { return g * __builtin_amdgcn_rcpf(1.f + __builtin_amdgcn_exp2f(-1.4426950408889634f * g)) * u; }
struct EpiSwiGLU {
    static constexpr bool PERM = true, AFTER_DRAIN = false;
    bf16_t* O; int ldc; const float* ssq;
    __device__ __forceinline__ void operator()(const f32x4 (&acc)[2][2][4][2], const Unit& u, int wr, int wc, int fr, int fq) const {
        const int row0 = u.pm * BM + wr * 64 + fr; const int col0 = u.pn * HALF + wc * 32 + 8 * fq;
#pragma unroll
        for (int ai = 0; ai < 2; ++ai)
#pragma unroll
            for (int m = 0; m < 4; ++m) { const int row = row0 + ai * HALF + m * 16; const float rs = row_inv(ssq, row, 4, 1.f / 1024.f); bf16_t* rowp = O + (size_t)row * ldc + col0;
                const f32x4 g0 = acc[ai][0][m][0] * rs, g1 = acc[ai][0][m][1] * rs, u0 = acc[ai][1][m][0] * rs, u1 = acc[ai][1][m][1] * rs;
                u32x4 w; w.x = cvt_pk_bf16(silu_mul(g0[0], u0[0]), silu_mul(g0[1], u0[1])); w.y = cvt_pk_bf16(silu_mul(g0[2], u0[2]), silu_mul(g0[3], u0[3]));
                w.z = cvt_pk_bf16(silu_mul(g1[0], u1[0]), silu_mul(g1[1], u1[1])); w.w = cvt_pk_bf16(silu_mul(g1[2], u1[2]), silu_mul(g1[3], u1[3]));
                *(u32x4*)rowp = w; }
    }
};
struct EpiResAdd {
    static constexpr bool PERM = true, AFTER_DRAIN = false;
    bf16_t* hb; float* ssq_out; int ldc;
    __device__ __forceinline__ void operator()(const f32x4 (&acc)[2][2][4][2], const Unit& u, int wr, int wc, int fr, int fq) const {
        const int row0 = u.pm * BM + wr * 64 + fr; const int col0 = u.pn * BM + wc * 32 + 8 * fq;
#pragma unroll
        for (int ai = 0; ai < 2; ++ai)
#pragma unroll
            for (int m = 0; m < 4; ++m) { const int row = row0 + ai * HALF + m * 16; bf16_t* hp = hb + (size_t)row * ldc + col0; float ss = 0.f;
#pragma unroll
                for (int bj = 0; bj < 2; ++bj) { u32x4* p = (u32x4*)(hp + bj * HALF); const u32x4 hw = *p;
                    f32x4 v0 = acc[ai][bj][m][0], v1 = acc[ai][bj][m][1];
                    v0[0] += __uint_as_float(hw.x << 16); v0[1] += __uint_as_float(hw.x & 0xffff0000u); v0[2] += __uint_as_float(hw.y << 16); v0[3] += __uint_as_float(hw.y & 0xffff0000u);
                    v1[0] += __uint_as_float(hw.z << 16); v1[1] += __uint_as_float(hw.z & 0xffff0000u); v1[2] += __uint_as_float(hw.w << 16); v1[3] += __uint_as_float(hw.w & 0xffff0000u);
                    ss += ((v0[0] * v0[0] + v0[1] * v0[1]) + (v0[2] * v0[2] + v0[3] * v0[3])) + ((v1[0] * v1[0] + v1[1] * v1[1]) + (v1[2] * v1[2] + v1[3] * v1[3]));
                    u32x4 w; w.x = cvt_pk_bf16(v0[0], v0[1]); w.y = cvt_pk_bf16(v0[2], v0[3]); w.z = cvt_pk_bf16(v1[0], v1[1]); w.w = cvt_pk_bf16(v1[2], v1[3]); *p = w; }
                ss += __shfl_xor(ss, 16); ss += __shfl_xor(ss, 32);
                if (fq == 0) ssq_out[(size_t)row * 16 + 4 * u.pn + wc] = ss; }
    }
};
struct EpiNormOut {
    static constexpr bool PERM = false, AFTER_DRAIN = false;
    bf16_t* O; int ldc; const float* ssq_in; float* ssq_out; int rope_pn; const float* cs; bf16_t* KR; unsigned* kmax;
    __device__ __forceinline__ void operator()(const f32x4 (&acc)[2][2][4][2], const Unit& u, int wr, int wc, int fr, int fq) const {
        const int row0 = u.pm * BM + wr * 64 + fr;
        if (u.pn == rope_pn) {
            if (wc == 0) { float mr = 0.f;
#pragma unroll
                for (int ai = 0; ai < 2; ++ai)
#pragma unroll
                    for (int m = 0; m < 4; ++m) { const int row = row0 + ai * HALF + m * 16; const float rs = row_inv(ssq_in, row, 4, 1.f / 1024.f);
                        const f32x4 x1 = acc[ai][0][m][0] * rs, x2 = acc[ai][0][m][1] * rs; const f32x4 c = *(const f32x4*)(cs + (size_t)row * 32 + 4 * fq), s = *(const f32x4*)(cs + (size_t)row * 32 + 16 + 4 * fq);
                        const f32x4 o1 = x1 * c - x2 * s, o2 = x1 * s + x2 * c;
                        u32x2 w1, w2; w1.x = cvt_pk_bf16(o1[0], o1[1]); w1.y = cvt_pk_bf16(o1[2], o1[3]); w2.x = cvt_pk_bf16(o2[0], o2[1]); w2.y = cvt_pk_bf16(o2[2], o2[3]);
                        *(u32x2*)(KR + (size_t)row * 32 + 4 * fq) = w1; *(u32x2*)(KR + (size_t)row * 32 + 16 + 4 * fq) = w2;
                        float sb = ((o1[0] * o1[0] + o1[1] * o1[1]) + (o1[2] * o1[2] + o1[3] * o1[3])) + ((o2[0] * o2[0] + o2[1] * o2[1]) + (o2[2] * o2[2] + o2[3] * o2[3]));
                        sb += __shfl_xor(sb, 16); sb += __shfl_xor(sb, 32); mr = fmaxf(mr, sb); }
#pragma unroll
                for (int o = 1; o < 16; o <<= 1) mr = fmaxf(mr, __shfl_xor(mr, o));
                if (kmax && fr == 0 && fq == 0) { const unsigned um = __float_as_uint(mr); if (um > __hip_atomic_load(kmax + 32, __ATOMIC_RELAXED, __HIP_MEMORY_SCOPE_AGENT)) atomicMax(kmax + 32, um); }
            }
            return;
        }
        const int col0 = u.pn * BM + wc * 32 + 4 * fq;
#pragma unroll
        for (int ai = 0; ai < 2; ++ai)
#pragma unroll
            for (int m = 0; m < 4; ++m) { const int row = row0 + ai * HALF + m * 16; const float rs = row_inv(ssq_in, row, 4, 1.f / 1024.f); bf16_t* op = O + (size_t)row * ldc + col0; float ss = 0.f;
#pragma unroll
                for (int bj = 0; bj < 2; ++bj)
#pragma unroll
                    for (int n = 0; n < 2; ++n) { const f32x4 v = acc[ai][bj][m][n] * rs; ss += (v[0] * v[0] + v[1] * v[1]) + (v[2] * v[2] + v[3] * v[3]);
                        u32x2 w; w.x = cvt_pk_bf16(v[0], v[1]); w.y = cvt_pk_bf16(v[2], v[3]); *(u32x2*)(op + bj * HALF + n * 16) = w; }
                ss += __shfl_xor(ss, 16); ss += __shfl_xor(ss, 32);
                if (fq == 0) ssq_out[(size_t)row * 16 + 4 * u.pn + wc] = ss; }
    }
};
template <class Epi, class Sched, bool ALIGN_EPI = false, bool SP2 = false>
__device__ __forceinline__ void gemm_phase(PG8_LAS unsigned char* lds, const Gemm g, const Sched& S, const Epi& E) {
    int tid_o = threadIdx.x; asm volatile("" : "+v"(tid_o)); const int tid = tid_o, wid = __builtin_amdgcn_readfirstlane(tid >> 6), lane = tid & 63, wr = wid >> 2, wc = wid & 3, fr = lane & 15, fq = lane >> 4;
    const int K = g.K, nt = K / BK;
    unsigned voffA[2], voffB[2];
#pragma unroll
    for (int i = 0; i < 2; ++i) { int R, C; stage_rc(tid * 16 + i * 8192, R, C); const int Rb = Epi::PERM ? ((R & ~31) + perm32(R & 31)) : R;
        voffA[i] = (unsigned)(R * K + C) * 2u; voffB[i] = (unsigned)(Rb * K + C) * 2u; }
    const size_t kstep = (size_t)(BK * 2);
    const size_t hstep = (size_t)HALF * K * 2;
    const size_t tstep = 2 * hstep;
    const unsigned ldsw = (unsigned)wid * 1024u;
    const int aoff = lds_byte(wr * 64 + fr, fq * 8), boff = lds_byte(wc * 32 + fr, fq * 8);
#define PG8_SA(b, h) (((b) * 2 + (h)) * HTB)
#define PG8_SB(b, h) ((4 + (b) * 2 + (h)) * HTB)
#define PG8_STAGE(bufoff, gbase, voff) do { _Pragma("unroll") for (int _i = 0; _i < 2; ++_i) \
        __builtin_amdgcn_global_load_lds((const unsigned*)((const char*)(gbase) + (voff)[_i]), (PG8_LAS unsigned*)(lds + (bufoff) + ldsw + _i * 8192), 16, 0, 0); } while (0)
#define PG8_LDA(dst, b, h) do { _Pragma("unroll") for (int m = 0; m < 4; ++m) _Pragma("unroll") for (int k = 0; k < 2; ++k) dst[m][k] = *(const PG8_LAS bf16x8*)(lds + PG8_SA(b, h) + aoff + m * 2048 + k * 1024); } while (0)
#define PG8_LDB(dst, b, h) do { _Pragma("unroll") for (int n = 0; n < 2; ++n) _Pragma("unroll") for (int k = 0; k < 2; ++k) dst[n][k] = *(const PG8_LAS bf16x8*)(lds + PG8_SB(b, h) + boff + n * 2048 + k * 1024); } while (0)
#define PG8_MMA(ai, bj, At, Bt) do { __builtin_amdgcn_s_setprio(1); _Pragma("unroll") for (int m = 0; m < 4; ++m) _Pragma("unroll") for (int n = 0; n < 2; ++n) _Pragma("unroll") for (int k = 0; k < 2; ++k) \
        acc[ai][bj][m][n] = __builtin_amdgcn_mfma_f32_16x16x32_bf16(Bt[n][k], At[m][k], acc[ai][bj][m][n], 0, 0, 0); __builtin_amdgcn_s_setprio(0); } while (0)
#define PG8_WAIT_V(n) asm volatile("s_waitcnt vmcnt(" #n ")" ::: "memory")
#define PG8_WAIT_L(n) asm volatile("s_waitcnt lgkmcnt(" #n ")" ::: "memory")
#define PG8_BAR __builtin_amdgcn_s_barrier()
#define PG8_SCHED __builtin_amdgcn_sched_barrier(0)
    Unit cur, nxt; int ui = 0;
    if (!S.next(0, cur)) return;
    f32x4 acc[2][2][4][2];
#pragma unroll
    for (int a = 0; a < 2; ++a)
#pragma unroll
        for (int b = 0; b < 2; ++b)
#pragma unroll
            for (int m = 0; m < 4; ++m)
#pragma unroll
                for (int n = 0; n < 2; ++n) acc[a][b][m][n] = (f32x4){0.f, 0.f, 0.f, 0.f};
    bf16x8 At[4][2], B0[2][2], B1[2][2];
    const char* cA = (const char*)g.A + (size_t)cur.pm * tstep; const char* cB = (const char*)g.Bt + (size_t)cur.pn * tstep;
    S.a_ready(cur);
    if constexpr (SP2) {
        PG8_STAGE(PG8_SB(0, 0), cB, voffB); PG8_STAGE(PG8_SB(0, 1), cB + hstep, voffB); PG8_STAGE(PG8_SA(0, 0), cA, voffA); PG8_STAGE(PG8_SA(0, 1), cA + hstep, voffA);
        if (wr == 1) PG8_BAR;
        PG8_WAIT_V(2); PG8_BAR;
        PG8_STAGE(PG8_SB(1, 0), cB + kstep, voffB); PG8_STAGE(PG8_SA(1, 0), cA + kstep, voffA); PG8_STAGE(PG8_SB(1, 1), cB + hstep + kstep, voffB);
        PG8_WAIT_V(6); PG8_BAR;
    } else {
        PG8_STAGE(PG8_SB(0, 0), cB, voffB); PG8_STAGE(PG8_SA(0, 0), cA, voffA); PG8_STAGE(PG8_SB(0, 1), cB + hstep, voffB); PG8_STAGE(PG8_SA(0, 1), cA + hstep, voffA);
        if (wr == 1) PG8_BAR;
        PG8_WAIT_V(4); PG8_BAR;
        PG8_STAGE(PG8_SB(1, 0), cB + kstep, voffB); PG8_STAGE(PG8_SA(1, 0), cA + kstep, voffA); PG8_STAGE(PG8_SB(1, 1), cB + hstep + kstep, voffB);
        PG8_WAIT_V(6); PG8_BAR;
    }
    for (;;) {
        const bool has_next = S.next(ui + 1, nxt);
        const char* nA = has_next ? (const char*)g.A + (size_t)nxt.pm * tstep : cA; const char* nB = has_next ? (const char*)g.Bt + (size_t)nxt.pn * tstep : cB;
        for (int t = 0; t < nt; t += 2) {
            const bool last = (t == nt - 2);
            const char* a1 = cA + (size_t)(t + 1) * kstep;
            const char* a2 = last ? nA : cA + (size_t)(t + 2) * kstep; const char* b2 = last ? nB : cB + (size_t)(t + 2) * kstep;
            const char* a3 = a2 + kstep; const char* b3 = b2 + kstep;
            if (last && has_next) S.a_ready(nxt);
            if constexpr (SP2) {
            PG8_LDB(B0, 0, 0); PG8_LDB(B1, 0, 1); PG8_SCHED; PG8_LDA(At, 0, 0); PG8_STAGE(PG8_SA(1, 1), a1 + hstep, voffA);
            PG8_WAIT_V(8); PG8_WAIT_L(0); PG8_BAR; PG8_MMA(0, 0, At, B0); PG8_MMA(0, 1, At, B1); PG8_BAR; PG8_SCHED;
            PG8_LDA(At, 0, 1); PG8_STAGE(PG8_SB(0, 0), b2, voffB); PG8_STAGE(PG8_SB(0, 1), b2 + hstep, voffB); PG8_STAGE(PG8_SA(0, 0), a2, voffA);
            PG8_WAIT_V(8); PG8_WAIT_L(0); PG8_BAR; PG8_MMA(1, 0, At, B0); PG8_MMA(1, 1, At, B1); PG8_BAR; PG8_SCHED;
            PG8_LDB(B0, 1, 0); PG8_LDB(B1, 1, 1); PG8_SCHED; PG8_LDA(At, 1, 0); PG8_STAGE(PG8_SA(0, 1), a2 + hstep, voffA);
            PG8_WAIT_V(8); PG8_WAIT_L(0); PG8_BAR; PG8_MMA(0, 0, At, B0); PG8_MMA(0, 1, At, B1); PG8_BAR; PG8_SCHED;
            PG8_LDA(At, 1, 1); PG8_STAGE(PG8_SB(1, 0), b3, voffB); PG8_STAGE(PG8_SB(1, 1), b3 + hstep, voffB); PG8_STAGE(PG8_SA(1, 0), a3, voffA);
            PG8_WAIT_V(8); PG8_WAIT_L(0); PG8_BAR; PG8_MMA(1, 0, At, B0); PG8_MMA(1, 1, At, B1); PG8_BAR; PG8_SCHED;
            } else {
            PG8_LDB(B0, 0, 0); PG8_SCHED; PG8_LDA(At, 0, 0); PG8_STAGE(PG8_SA(1, 1), a1 + hstep, voffA);
            PG8_WAIT_L(8); PG8_BAR; PG8_WAIT_L(0); PG8_MMA(0, 0, At, B0); PG8_BAR; PG8_SCHED;
            PG8_LDB(B1, 0, 1); PG8_STAGE(PG8_SB(0, 0), b2, voffB);
            PG8_BAR; PG8_WAIT_L(0); PG8_MMA(0, 1, At, B1); PG8_BAR;
            PG8_LDA(At, 0, 1); PG8_STAGE(PG8_SA(0, 0), a2, voffA);
            PG8_BAR; PG8_WAIT_L(0); PG8_MMA(1, 0, At, B0); PG8_BAR; PG8_SCHED;
            PG8_STAGE(PG8_SB(0, 1), b2 + hstep, voffB);
            PG8_WAIT_V(6); PG8_BAR; PG8_MMA(1, 1, At, B1); PG8_BAR;
            PG8_LDB(B0, 1, 0); PG8_SCHED; PG8_LDA(At, 1, 0); PG8_STAGE(PG8_SA(0, 1), a2 + hstep, voffA);
            PG8_WAIT_L(8); PG8_BAR; PG8_WAIT_L(0); PG8_MMA(0, 0, At, B0); PG8_BAR; PG8_SCHED;
            PG8_LDB(B1, 1, 1); PG8_STAGE(PG8_SB(1, 0), b3, voffB);
            PG8_BAR; PG8_WAIT_L(0); PG8_MMA(0, 1, At, B1); PG8_BAR;
            PG8_LDA(At, 1, 1); PG8_STAGE(PG8_SA(1, 0), a3, voffA);
            PG8_BAR; PG8_WAIT_L(0); PG8_MMA(1, 0, At, B0); PG8_BAR; PG8_SCHED;
            PG8_STAGE(PG8_SB(1, 1), b3 + hstep, voffB);
            PG8_WAIT_V(6); PG8_BAR; PG8_MMA(1, 1, At, B1); PG8_BAR;
            }
        }
        if constexpr (ALIGN_EPI) { if (wr == 0) PG8_BAR; }
        if constexpr (!Epi::AFTER_DRAIN) { E(acc, cur, wr, wc, fr, fq); S.done(cur); }
        if (!has_next) break;
#pragma unroll
        for (int a = 0; a < 2; ++a)
#pragma unroll
            for (int b = 0; b < 2; ++b)
#pragma unroll
                for (int m = 0; m < 4; ++m)
#pragma unroll
                    for (int n = 0; n < 2; ++n) acc[a][b][m][n] = (f32x4){0.f, 0.f, 0.f, 0.f};
        cur = nxt; cA = nA; cB = nB; ++ui;
        if constexpr (ALIGN_EPI) { if (wr == 1) PG8_BAR; }
    }
    PG8_WAIT_V(0);
    if constexpr (!ALIGN_EPI) { if (wr == 0) PG8_BAR; }
    PG8_BAR;
    if constexpr (Epi::AFTER_DRAIN) { E.fused(acc, cur, wr, wc, fr, fq, lds, wid, lane); S.done(cur); }
#undef PG8_SA
#undef PG8_SB
#undef PG8_STAGE
#undef PG8_LDA
#undef PG8_LDB
#undef PG8_MMA
#undef PG8_WAIT_V
#undef PG8_WAIT_L
#undef PG8_BAR
#undef PG8_SCHED
}
}
namespace att {
#define ALAS __attribute__((address_space(3)))
#define AGAS __attribute__((address_space(1)))
typedef unsigned short bf16;
typedef short bf16x8 __attribute__((ext_vector_type(8)));
typedef short s16x4 __attribute__((ext_vector_type(4)));
typedef short v4i16_t __attribute__((ext_vector_type(4)));
typedef float f32x16 __attribute__((ext_vector_type(16)));
typedef float f32x4 __attribute__((ext_vector_type(4)));
typedef unsigned u32x4 __attribute__((ext_vector_type(4)));
constexpr int SEQ = 16384;
constexpr float THR = 8.f;
#ifndef ATT_PFV
#define ATT_PFV 1
#endif
__device__ __forceinline__ int crow(int r, int hi) { return (r & 3) + 8 * (r >> 2) + 4 * hi; }
typedef float f32x2_t __attribute__((ext_vector_type(2))); typedef __bf16 bf16x2_t __attribute__((ext_vector_type(2)));
__device__ __forceinline__ unsigned cvtpk(float lo, float hi) { f32x2_t v = {lo, hi}; bf16x2_t b = __builtin_convertvector(v, bf16x2_t); return __builtin_bit_cast(unsigned, b); }
__device__ __forceinline__ float bf2f(short v) { return __uint_as_float(((unsigned)(unsigned short)v) << 16); }
__device__ __forceinline__ s16x4 vtr(const ALAS char* p) { return __builtin_bit_cast(s16x4, __builtin_amdgcn_ds_read_tr16_b64_v4i16((ALAS v4i16_t*)p)); }
__device__ __forceinline__ float hmax(float m) { auto rr = __builtin_amdgcn_permlane32_swap(__float_as_uint(m), __float_as_uint(m), false, false); return fmaxf(__uint_as_float(rr[0]), __uint_as_float(rr[1])); }
__device__ __forceinline__ float hsum(float m) { auto rr = __builtin_amdgcn_permlane32_swap(__float_as_uint(m), __float_as_uint(m), false, false); return __uint_as_float(rr[0]) + __uint_as_float(rr[1]); }
__device__ __forceinline__ float max3(float a, float b, float c) { return fmaxf(fmaxf(a, b), c); }
__device__ __forceinline__ float tilemax(const f32x16& p0, const f32x16& p1) {
    float a = max3(p0[0], p0[1], p1[0]), b = max3(p0[2], p0[3], p1[1]); a = max3(a, p1[2], p1[3]);
#pragma unroll
    for (int r = 4; r < 16; r += 4) { a = max3(a, p0[r], p0[r + 1]); b = max3(b, p0[r + 2], p0[r + 3]); a = max3(a, p1[r], p1[r + 1]); b = max3(b, p1[r + 2], p1[r + 3]); }
    return hmax(fmaxf(a, b));
}
__device__ __forceinline__ void cmask(f32x16& p0, f32x16& p1, int jb, int qrel, int hi) {
    const int kbase = 64 * jb + 4 * hi;
#pragma unroll
    for (int r = 0; r < 16; ++r) { const int kv = kbase + (r & 3) + 8 * (r >> 2); if (kv > qrel) p0[r] = -INFINITY; if (kv + 32 > qrel) p1[r] = -INFINITY; }
}
#define ATT_MFMA(a, b, c) __builtin_amdgcn_mfma_f32_32x32x16_bf16(a, b, c, 0, 0, 0)
#define ATT_SGBAR(mask, n) __builtin_amdgcn_sched_group_barrier(mask, n, 0)

template <bool MLA> struct Cfg { static constexpr int NK = MLA ? 6 : 4, KT = MLA ? 12288 : 8192, VT = 8192, STG = 2 * KT + 2 * VT + 512, L_WS = 2 * STG, L_END = L_WS + 2048; };

template <bool MLA, bool FASTREF = false>
__device__ __forceinline__ void attn_unit(int h, int qb, bool rev, const AGAS bf16* Q, const AGAS bf16* __restrict__ Kn, const AGAS bf16* __restrict__ Kr, const AGAS bf16* __restrict__ V, AGAS bf16* O,
                                          const AGAS float* __restrict__ cbg, const AGAS float* __restrict__ cs, ALAS char* shm) {
    typedef Cfg<MLA> C;
    constexpr int QP = MLA ? 1536 : 1024, QH = MLA ? 96 : 64, NK = C::NK, KT = C::KT, VT = C::VT, STG = C::STG;
    int tid_o = threadIdx.x; asm volatile("" : "+v"(tid_o)); const int tid = tid_o, lane = tid & 63, r32 = lane & 31, hi = lane >> 5; const int wid = __builtin_amdgcn_readfirstlane(tid >> 6);
    const int q0 = qb * 256, NI_all = 2 * (qb + 1);
    const AGAS float* cbu = cbg + (size_t)h * SEQ;
    float cbreg = 0.f; float mu = 0.f; (void)cbreg; (void)mu;
    if constexpr (FASTREF) mu = __uint_as_float(__builtin_amdgcn_readfirstlane(__float_as_uint(cbu[q0 + 255] + sqrtf(cs[h] * cs[16 + h]) * 1.02f + 0.25f)));
    ALAS char* kdst = shm + wid * 1024;
    ALAS char* vdst = shm + 2 * KT + wid * 1024;
    ALAS char* krdst = shm + (wid >> 2) * KT + (8 + (wid & 3)) * 1024;
    ALAS char* cbdst = shm + 2 * KT + 2 * VT + (wid & 1) * 256;
#define ATT_GL16(src_, dst_) __builtin_amdgcn_global_load_lds((const AGAS unsigned*)(src_), (ALAS unsigned*)(dst_), 16, 0, 0)
#define ATT_DMA(it_, s_) do { const size_t ko_ = (size_t)(it_) * 128 * 1024; const int so_ = (s_) * STG; \
        int ln_ = __builtin_amdgcn_mbcnt_hi(~0u, __builtin_amdgcn_mbcnt_lo(~0u, 0u)); asm volatile("" : "+v"(ln_)); \
        const AGAS bf16* ks_ = Kn + ko_ + ((unsigned)ln_ * 1024u + (unsigned)(h * 64 + wid * 8)); \
        const AGAS bf16* vs_ = V + ko_ + ((unsigned)(16 * (wid & 3) + (ln_ >> 2)) * 1024u + (unsigned)(h * 64 + (wid >> 2) * 32 + (ln_ & 3) * 8)); \
        ATT_GL16(ks_, kdst + so_); ATT_GL16(ks_ + 64 * 1024, kdst + so_ + KT); ATT_GL16(vs_, vdst + so_); ATT_GL16(vs_ + 64 * 1024, vdst + so_ + VT); \
        if constexpr (MLA) ATT_GL16(Kr + (size_t)(it_) * 128 * 32 + ((unsigned)(64 * (wid >> 2) + ln_) * 32u + (unsigned)((wid & 3) * 8)), krdst + so_); \
        else if constexpr (!FASTREF) { if (wid < 2) __builtin_amdgcn_global_load_lds((const AGAS unsigned*)(cbu + (size_t)(it_) * 128 + ((wid & 1) * 64 + ln_)), (ALAS unsigned*)(cbdst + so_), 4, 0, 0); } \
        else { if (wid < 2) cbreg = cbu[(size_t)(it_) * 128 + ((wid & 1) * 64 + ln_)]; } } while (0)
#define ATT_CBSTORE(s_) do { if constexpr (FASTREF) { if (wid < 2) { int ln_ = __builtin_amdgcn_mbcnt_hi(~0u, __builtin_amdgcn_mbcnt_lo(~0u, 0u)); asm volatile("" : "+v"(ln_)); \
        *(ALAS float*)(cbdst + (s_) * STG + 4 * ln_) = cbreg - mu; } } } while (0)
#define ATT_SYNC() do { asm volatile("s_waitcnt vmcnt(0)" ::: "memory"); __syncthreads(); } while (0)
    const bool dma_early = MLA || rev;
    if (dma_early) ATT_DMA(rev ? NI_all - 1 : 0, 0);
    const AGAS bf16* Qw = Q + (size_t)(q0 + wid * 32 + r32) * QP + h * QH;
    bf16x8 qr[NK];
#pragma unroll
    for (int d0 = 0; d0 < NK; ++d0) qr[d0] = *(const AGAS bf16x8*)(Qw + d0 * 16 + hi * 8);
    if constexpr (MLA) {
        const AGAS float* cp = cs + (size_t)(q0 + wid * 32 + r32) * 32 + hi * 8;
        const f32x4 c0 = *(const AGAS f32x4*)cp, c1 = *(const AGAS f32x4*)(cp + 4), s0 = *(const AGAS f32x4*)(cp + 16), s1 = *(const AGAS f32x4*)(cp + 20);
        bf16x8 a = qr[4], b = qr[5]; unsigned oa[4], ob[4];
#pragma unroll
        for (int j = 0; j < 8; j += 2) {
            const float x1a = bf2f(a[j]), x2a = bf2f(b[j]), x1b = bf2f(a[j + 1]), x2b = bf2f(b[j + 1]);
            const float ca = j < 4 ? c0[j] : c1[j - 4], cb_ = j < 4 ? c0[j + 1] : c1[j - 3], sa = j < 4 ? s0[j] : s1[j - 4], sb = j < 4 ? s0[j + 1] : s1[j - 3];
            oa[j / 2] = cvtpk(x1a * ca - x2a * sa, x1b * cb_ - x2b * sb);
            ob[j / 2] = cvtpk(x1a * sa + x2a * ca, x1b * sb + x2b * cb_);
        }
        qr[4] = __builtin_bit_cast(bf16x8, (u32x4){oa[0], oa[1], oa[2], oa[3]});
        qr[5] = __builtin_bit_cast(bf16x8, (u32x4){ob[0], ob[1], ob[2], ob[3]});
    }
    int it0 = 0;
    if constexpr (!MLA) {
        const AGAS float* cbu_s = cbg + (size_t)h * SEQ;
        const float thr = __uint_as_float(__builtin_amdgcn_readfirstlane(__float_as_uint(cbg[(size_t)h * SEQ + q0 + (FASTREF ? 255 : 0)] - 150.0f)));
        const int ntile = 2 * NI_all;
        const int j1 = 4 * lane + 3; const float v1 = j1 < ntile ? cbu_s[64 * j1 + 63] : 3.0e38f;
        const int g = __builtin_ctzll(__ballot(v1 >= thr));
        const int j2 = 4 * g + (lane & 3); const float v2 = j2 < ntile ? cbu_s[64 * j2 + 63] : 3.0e38f;
        const int lo = 4 * g + __builtin_ctzll(__ballot(v2 >= thr) | 8ull);
        it0 = __builtin_amdgcn_readfirstlane(lo >> 1);
        if (it0 > NI_all - 2) it0 = NI_all - 2;
    }
    const int NI = NI_all;
    if (!dma_early) ATT_DMA(it0, 0);
    ATT_CBSTORE(0);
    ATT_SYNC();
    ALAS float* wsf = (ALAS float*)(shm + C::L_WS) + wid * 64;
    const ALAS char* kb0 = shm + hi * 1024 + r32 * 16;
    const ALAS char* vp0 = shm + 2 * KT + ((lane >> 4) & 1) * 32 + (lane & 3) * 8 + (4 * hi + ((lane & 15) >> 2)) * 64;
    const ALAS float* cb0 = (const ALAS float*)(shm + 2 * KT + 2 * VT) + 4 * hi;
    float mhat = -3.0e38f, l_reg = 0.f; f32x16 o0 = f32x16{}, o1 = f32x16{};
    if constexpr (!MLA && !FASTREF) {
        float qn = 0.f;
#pragma unroll
        for (int d0 = 0; d0 < NK; ++d0)
#pragma unroll
            for (int j = 0; j < 8; ++j) { const float qv = bf2f(qr[d0][j]); qn += qv * qv; }
        qn = hsum(qn);
        mhat = cbg[(size_t)h * SEQ + q0 + wid * 32 + r32] + sqrtf(qn * cs[16 + h]) * 1.02f + 0.25f;
    }
    f32x16 negm = f32x16{};
    if constexpr (MLA) {
        float qn = 0.f;
#pragma unroll
        for (int d0 = 0; d0 < NK; ++d0)
#pragma unroll
            for (int j = 0; j < 8; ++j) { const float qv = bf2f(qr[d0][j]); qn += qv * qv; }
        qn = hsum(qn);
        const float k2 = cbg[2 * h] + cbg[2 * h + 1] + cbg[32];
        mhat = sqrtf(qn * k2) * 1.02f + 0.25f;
#pragma unroll
        for (int r = 0; r < 16; ++r) negm[r] = -mhat;
        asm volatile("" : "+v"(negm));
    }
    const int qrel = wid * 32 + r32;

#define ATT_LOADK(KF, P0, P1, s_, j_) do { const ALAS char* kb_ = kb0 + (s_) * STG + (j_) * KT; \
        _Pragma("unroll") for (int d0 = 0; d0 < NK; ++d0) { KF[2 * d0] = *(const ALAS bf16x8*)(kb_ + d0 * 2048); KF[2 * d0 + 1] = *(const ALAS bf16x8*)(kb_ + d0 * 2048 + 512); } \
        if constexpr (!MLA) { const ALAS float* cbt_ = cb0 + (s_) * (STG / 4) + 64 * (j_); \
            _Pragma("unroll") for (int g = 0; g < 4; ++g) { const f32x4 ca_ = *(const ALAS f32x4*)(cbt_ + 8 * g), cb2_ = *(const ALAS f32x4*)(cbt_ + 32 + 8 * g); \
                _Pragma("unroll") for (int i = 0; i < 4; ++i) { P0[4 * g + i] = ca_[i]; P1[4 * g + i] = cb2_[i]; } } } \
        else { P0 = negm; P1 = negm; } } while (0)
#define ATT_MMAQK(P0, P1, KF) do { _Pragma("unroll") for (int d0 = 0; d0 < NK; ++d0) { P0 = ATT_MFMA(KF[2 * d0], qr[d0], P0); P1 = ATT_MFMA(KF[2 * d0 + 1], qr[d0], P1); } } while (0)
#define ATT_DECIDE(P0, P1, need_) do { const float rm_ = tilemax(P0, P1); need_ = __any(rm_ > mhat + THR); \
        if (need_) { const float mn_ = fmaxf(mhat, rm_); const float f_ = __builtin_amdgcn_exp2f(mhat - mn_); mhat = mn_; l_reg *= f_; if (hi == 0) wsf[r32] = f_; } } while (0)
#define ATT_ORESC() do { _Pragma("unroll") for (int g = 0; g < 4; ++g) { const f32x4 fv_ = *(const ALAS f32x4*)(wsf + 8 * g + 4 * hi); \
        _Pragma("unroll") for (int i = 0; i < 4; ++i) { o0[4 * g + i] *= fv_[i]; o1[4 * g + i] *= fv_[i]; } } } while (0)
#define ATT_EXP(P0, P1, PA) do { float sa_ = 0.f, sb_ = 0.f; \
        _Pragma("unroll") for (int r = 0; r < 16; ++r) { if constexpr (MLA || FASTREF) { P0[r] = __builtin_amdgcn_exp2f(P0[r]); P1[r] = __builtin_amdgcn_exp2f(P1[r]); } else { P0[r] = __builtin_amdgcn_exp2f(P0[r] - mhat); P1[r] = __builtin_amdgcn_exp2f(P1[r] - mhat); } sa_ += P0[r]; asm("" : "+v"(sa_)); sb_ += P1[r]; asm("" : "+v"(sb_)); } \
        l_reg += sa_ + sb_; \
        PA[0] = __builtin_bit_cast(bf16x8, (u32x4){cvtpk(P0[0], P0[1]), cvtpk(P0[2], P0[3]), cvtpk(P0[4], P0[5]), cvtpk(P0[6], P0[7])}); \
        PA[1] = __builtin_bit_cast(bf16x8, (u32x4){cvtpk(P0[8], P0[9]), cvtpk(P0[10], P0[11]), cvtpk(P0[12], P0[13]), cvtpk(P0[14], P0[15])}); \
        PA[2] = __builtin_bit_cast(bf16x8, (u32x4){cvtpk(P1[0], P1[1]), cvtpk(P1[2], P1[3]), cvtpk(P1[4], P1[5]), cvtpk(P1[6], P1[7])}); \
        PA[3] = __builtin_bit_cast(bf16x8, (u32x4){cvtpk(P1[8], P1[9]), cvtpk(P1[10], P1[11]), cvtpk(P1[12], P1[13]), cvtpk(P1[14], P1[15])}); } while (0)
#define ATT_VF(vp_, d0, ks) ({ const s16x4 lo_ = vtr(vp_ + (d0) * 4096 + (ks) * 1024), hi_ = vtr(vp_ + (d0) * 4096 + (ks) * 1024 + 512); (bf16x8){lo_[0], lo_[1], lo_[2], lo_[3], hi_[0], hi_[1], hi_[2], hi_[3]}; })
#define ATT_LOADV(VF, s_, j_) do { const ALAS char* vp_ = vp0 + (s_) * STG + (j_) * VT; \
        _Pragma("unroll") for (int ks = 0; ks < 4; ++ks) { VF[2 * ks] = ATT_VF(vp_, 0, ks); VF[2 * ks + 1] = ATT_VF(vp_, 1, ks); } } while (0)
#define ATT_MMAPV(PA, VF) do { _Pragma("unroll") for (int ks = 0; ks < 4; ++ks) { o0 = ATT_MFMA(PA[ks], VF[2 * ks], o0); o1 = ATT_MFMA(PA[ks], VF[2 * ks + 1], o1); } } while (0)
#define ATT_INTERVAL(s_, BAND_, ib_) do { \
        f32x16 a0, a1, b0, b1; bf16x8 pa[4], pb[4], kfA[2 * NK], kfB[2 * NK], vfA[8], vfB[8]; \
        int ln_ = __builtin_amdgcn_mbcnt_hi(~0u, __builtin_amdgcn_mbcnt_lo(~0u, 0u)); asm volatile("" : "+v"(ln_));     \
        const int hi = ln_ >> 5, r32 = ln_ & 31; const int qrel = wid * 32 + r32; (void)qrel; \
        const ALAS char* kb0 = shm + hi * 1024 + r32 * 16; \
        const ALAS char* vp0 = shm + 2 * KT + ((ln_ >> 4) & 1) * 32 + (ln_ & 3) * 8 + (4 * hi + ((ln_ & 15) >> 2)) * 64; \
        const ALAS float* cb0 = (const ALAS float*)(shm + 2 * KT + 2 * VT) + 4 * hi; (void)cb0; \
          \
        __builtin_amdgcn_sched_barrier(0); \
        ATT_LOADK(kfA, a0, a1, s_, 0); \
        ATT_LOADK(kfB, b0, b1, s_, 1); \
        __builtin_amdgcn_sched_barrier(0); \
        ATT_MMAQK(a0, a1, kfA); \
        ATT_MMAQK(b0, b1, kfB); \
        __builtin_amdgcn_sched_barrier(0); \
        if (BAND_) { cmask(a0, a1, 2 * (ib_), qrel, hi); cmask(b0, b1, 2 * (ib_) + 1, qrel, hi); } \
        ATT_LOADV(vfA, s_, 0); \
        ATT_LOADV(vfB, s_, 1); \
        __builtin_amdgcn_sched_barrier(0); \
        ATT_EXP(a0, a1, pa); \
        ATT_EXP(b0, b1, pb); \
        asm volatile("" : "+v"(pa[0]), "+v"(pa[1]), "+v"(pa[2]), "+v"(pa[3]), "+v"(pb[0]), "+v"(pb[1]), "+v"(pb[2]), "+v"(pb[3]), "+v"(l_reg)); \
        __builtin_amdgcn_sched_barrier(0); \
        ATT_MMAPV(pa, vfA); \
        ATT_MMAPV(pb, vfB); \
        __builtin_amdgcn_sched_barrier(0); \
    } while (0)

    const int nint = NI - it0;
    for (int k = 0; k < nint; ++k) {
        const int it = rev ? NI - 1 - k : it0 + k, itn = rev ? it - 1 : it + 1, cur = k & 1, ib = it - (NI - 2);
        if (k + 1 < nint) ATT_DMA(itn, cur ^ 1);
        if (ib < 0) { if (cur == 0) ATT_INTERVAL(0, false, 0); else ATT_INTERVAL(1, false, 0); }
        else if (ib == 0 || wid >= 4) { if (cur == 0) ATT_INTERVAL(0, true, ib); else ATT_INTERVAL(1, true, ib); }
        if (k + 1 < nint) ATT_CBSTORE(cur ^ 1);
        ATT_SYNC();
    }
    l_reg = hsum(l_reg);
    if (hi == 0) wsf[32 + r32] = l_reg;
    float rli[16];
#pragma unroll
    for (int g = 0; g < 4; ++g) { const f32x4 lv = *(const ALAS f32x4*)(wsf + 32 + 8 * g + 4 * hi);
#pragma unroll
        for (int i = 0; i < 4; ++i) rli[4 * g + i] = __builtin_amdgcn_rcpf(lv[i]); }
    AGAS bf16* Ow = O + (size_t)(q0 + wid * 32) * 1024 + h * 64;
    ALAS bf16* stg = (ALAS bf16*)shm + wid * 2048;
#pragma unroll
    for (int r = 0; r < 16; ++r) { const int orow = crow(r, hi);
        stg[orow * 64 + r32] = (bf16)(cvtpk(o0[r] * rli[r], 0.f) & 0xffffu);
        stg[orow * 64 + 32 + r32] = (bf16)(cvtpk(o1[r] * rli[r], 0.f) & 0xffffu); }
#pragma unroll
    for (int i = 0; i < 4; ++i) { const int row = i * 8 + (lane >> 3), ch = lane & 7; const u32x4 v = *(const ALAS u32x4*)(stg + row * 64 + ch * 8); *(AGAS u32x4*)(Ow + (size_t)row * 1024 + ch * 8) = v; }
    __syncthreads();
#undef ATT_GL16
#undef ATT_DMA
#undef ATT_CBSTORE
#undef ATT_SYNC
#undef ATT_LOADK
#undef ATT_MMAQK
#undef ATT_LOADV
#undef ATT_MMAPV
#undef ATT_DECIDE
#undef ATT_ORESC
#undef ATT_EXP
#undef ATT_VF
#undef ATT_INTERVAL
}
#undef ALAS
#undef AGAS
}
#define GAS __attribute__((address_space(1)))
#define LAS __attribute__((address_space(3)))
typedef unsigned short bf16;
typedef unsigned v4u __attribute__((ext_vector_type(4)));
typedef unsigned v2u __attribute__((ext_vector_type(2)));
typedef float f32x4 __attribute__((ext_vector_type(4)));
#define XB_TMO      128
#define XB_XCNT(j)  (256  + 64 * (j))
#define XB_XSUB(j)  (1280 + 64 * (j))
#define XB_XGEN(j)  (2304 + 64 * (j))
#define XB_TOP      3328
#define XB_TOPGEN   3392
#define XCD_BAR_WORDS 3456
#define XB_SPIN_CAP (1u << 18)

__device__ __forceinline__ unsigned xb_ld(unsigned* p)              { return __hip_atomic_load(p, __ATOMIC_RELAXED, __HIP_MEMORY_SCOPE_AGENT); }
__device__ __forceinline__ unsigned xb_add(unsigned* p, unsigned v) { return __hip_atomic_fetch_add(p, v, __ATOMIC_RELAXED, __HIP_MEMORY_SCOPE_AGENT); }
__device__ __forceinline__ unsigned xb_xcc_id() { return (unsigned)__builtin_amdgcn_s_getreg((3 << 11) | 20) & 0xFu; }
#define XB_SPIN(cond, bar) do { unsigned _sp = 0; while (cond) { __builtin_amdgcn_s_sleep(1); \
    if ((++_sp & 255u) == 0u) { if (xb_ld(&(bar)[XB_TMO])) break; if (_sp > XB_SPIN_CAP) { atomicAdd(&(bar)[XB_TMO], 1u); break; } } } } while (0)

struct XcdBarrier {
    unsigned* bar; unsigned x;
    volatile LAS unsigned* st;
};

__device__ __forceinline__ XcdBarrier xcd_barrier_post(unsigned* bar, volatile LAS unsigned* st) {
    XcdBarrier b; b.bar = bar; b.x = xb_xcc_id(); b.st = st;
    if (threadIdx.x == 0) (void)xb_add(&bar[XB_XCNT(b.x)], 1u);
    return b;
}
__device__ __forceinline__ void xcd_barrier_complete(unsigned* bar, unsigned x, unsigned& nloc, unsigned& nx) {
    const unsigned G = gridDim.x * gridDim.y * gridDim.z;
    unsigned sum, cnt, mine, sp = 0u;
    for (;;) {
        sum = 0u; cnt = 0u; mine = 0u;
#pragma unroll
        for (unsigned j = 0; j < 16; ++j) { const unsigned c = xb_ld(&bar[XB_XCNT(j)]); sum += c; cnt += (c > 0u) ? 1u : 0u; mine = (j == x) ? c : mine; }
        if (sum == G) break;
        __builtin_amdgcn_s_sleep(1);
        if ((++sp & 255u) == 0u) { if (xb_ld(&bar[XB_TMO])) break; if (sp > XB_SPIN_CAP) { atomicAdd(&bar[XB_TMO], 1u); break; } }
    }
    nloc = mine > 0u ? mine : 1u; nx = cnt > 0u ? cnt : 1u;
}

__device__ __forceinline__ void xcd_barrier(const XcdBarrier& b) {
    asm volatile("s_waitcnt vmcnt(0)" ::: "memory");
    __syncthreads();
    if (threadIdx.x == 0) {
        unsigned* bar = b.bar;
        __builtin_amdgcn_s_waitcnt(0);
        unsigned nloc = b.st[0], nx = b.st[1];
        if (nloc == 0u) { xcd_barrier_complete(bar, b.x, nloc, nx); b.st[0] = nloc; b.st[1] = nx; }
        const unsigned old = xb_add(&bar[XB_XSUB(b.x)], 1u);
        const unsigned gen = old / nloc;
        if (old + 1u == (gen + 1u) * nloc) {
            __builtin_amdgcn_fence(__ATOMIC_RELEASE, "agent");
            asm volatile("s_waitcnt vmcnt(0)" ::: "memory");
            const unsigned og = xb_add(&bar[XB_TOP], 1u);
            const unsigned tg = og / nx;
            if (og + 1u == (tg + 1u) * nx) xb_add(&bar[XB_TOPGEN], 1u);
            else XB_SPIN(xb_ld(&bar[XB_TOPGEN]) == tg, bar);
            __builtin_amdgcn_fence(__ATOMIC_ACQUIRE, "agent");
            xb_add(&bar[XB_XGEN(b.x)], 1u);
            asm volatile("s_waitcnt vmcnt(0)" ::: "memory");
        } else {
            XB_SPIN(xb_ld(&bar[XB_XGEN(b.x)]) == gen, bar);
            __builtin_amdgcn_fence(__ATOMIC_ACQUIRE, "agent");
            asm volatile("s_waitcnt vmcnt(0)" ::: "memory");
        }
    }
    __syncthreads();
}
constexpr int SEQ = 16384, DM = 1024, DFF = 2816, NWAVES = 8;
constexpr int LDS_BYTES = 147456;
#ifndef SYNC_REP
#define SYNC_REP 1
#endif
#define GSYNC() do { for (int sr_ = 0; sr_ < SYNC_REP; ++sr_) { XcdBarrier b_; b_.bar = (unsigned*)(ws + WS_CTL); b_.x = xb_xcc_id(); b_.st = (volatile LAS unsigned*)(ldsp + MISC_OFF); xcd_barrier(b_); } } while (0)
#ifndef SCAN_REP
#define SCAN_REP 1
#endif
#ifndef GU_REP
#define GU_REP 1
#endif
#ifndef ATT_REPF
#define ATT_REPF 1
#endif
#ifndef ATT_REPM
#define ATT_REPM 1
#endif
constexpr float RMS_EPS = 1e-6f;
constexpr float LOG2E = 1.4426950408889634f;
constexpr float C2FOX = 0.125f * LOG2E;
constexpr float C2MLA = 0.10206207261596575f * LOG2E;
constexpr size_t MiB = 1u << 20;
constexpr size_t W_GU = 0, W_DN = 11 * MiB, W_O = 16 * MiB + 512 * 1024, W_A = 18 * MiB + 512 * 1024;
constexpr size_t W_DQ = W_A, W_UQ = 20 * MiB, W_KVA = 23 * MiB, W_UKV = 24 * MiB;
constexpr size_t WS_XN = 26 * MiB, WS_BIG = 58 * MiB;
constexpr size_t WS_Q = WS_BIG, WS_K = WS_BIG + 32 * MiB, WS_V = WS_BIG + 64 * MiB;
constexpr size_t WS_HH = WS_BIG;
constexpr size_t WS_CQ = WS_BIG + 48 * MiB, WS_QM = WS_BIG, WS_OM = WS_BIG + 48 * MiB;
constexpr size_t WS_CKV = WS_BIG + 80 * MiB;
constexpr size_t WS_KN = 154 * MiB, WS_VM = 186 * MiB, WS_KR = 218 * MiB, WS_CS = 219 * MiB, WS_LOGF = 221 * MiB, WS_CB = 222 * MiB, WS_CTL = 223 * MiB, WS_SSQH = 224 * MiB, WS_SSQC = 225 * MiB, WS_SSQK = 226 * MiB, WS_END = 227 * MiB;
constexpr int MISC_OFF = LDS_BYTES - 64, CTL_BYTES = 16384, KMAX_OFF = 14336, KMAXF_OFF = 14592;

__device__ __forceinline__ float wave_sum(float v) {
#pragma unroll
    for (int o = 1; o < 64; o <<= 1) v += __shfl_xor(v, o);
    return v;
}
__device__ __forceinline__ unsigned pk2(float lo, float hi) { return pg8::cvt_pk_bf16(lo, hi); }

__device__ __forceinline__ void tr_item(const float* W, int ldw, int Kd, int ncols, bf16* WT, int row_off, int mode, const float* gain, int item, LAS float* scr, int lane) {
    const int nblk = (ncols + 31) >> 5, kb = item / nblk, nb = item - kb * nblk, k0 = 64 * kb, n0 = 32 * nb;
    {
        const int c4 = n0 + 4 * (lane & 7); const bool cv = c4 < ncols; const float* src = W + (size_t)(k0 + (lane >> 3)) * ldw + c4;
#pragma unroll
        for (int i = 0; i < 8; ++i) { const f32x4 v = cv ? __builtin_nontemporal_load((const f32x4*)(src + (size_t)(8 * i) * ldw)) : (f32x4){0.f, 0.f, 0.f, 0.f};
            LAS float* d = scr + ((lane >> 3) + 8 * i) * 33 + 4 * (lane & 7); d[0] = v.x; d[1] = v.y; d[2] = v.z; d[3] = v.w; }
    }
    asm volatile("s_waitcnt lgkmcnt(0)" ::: "memory");
    const int c8 = lane & 7;
    f32x4 ga = (f32x4){1.f, 1.f, 1.f, 1.f}, gb = ga;
    if (gain) { ga = *(const f32x4*)(gain + k0 + 8 * c8); gb = *(const f32x4*)(gain + k0 + 8 * c8 + 4); }
#pragma unroll
    for (int j = 0; j < 4; ++j) { const int nl = (lane >> 3) + 8 * j, n = n0 + nl; const LAS float* s = scr + (8 * c8) * 33 + nl;
        v4u o; o.x = pk2(s[0 * 33] * ga.x, s[1 * 33] * ga.y); o.y = pk2(s[2 * 33] * ga.z, s[3 * 33] * ga.w); o.z = pk2(s[4 * 33] * gb.x, s[5 * 33] * gb.y); o.w = pk2(s[6 * 33] * gb.z, s[7 * 33] * gb.w);
        const int row = mode == 0 ? row_off + n : (256 * (n >> 7) + (n & 127) + (mode == 2 ? 128 : 0));
        if (n < ncols) *(v4u*)(WT + (size_t)row * Kd + k0 + 8 * c8) = o; }
    asm volatile("s_waitcnt lgkmcnt(0)" ::: "memory");
}
__device__ __forceinline__ void conv_job(const float* W, int ldw, int K, int ncols, bf16* WT, int row_off, int mode, const float* gain, int& base, int gw, int NGW, LAS float* scr, int lane) {
    const int nitems = (K >> 6) * ((ncols + 31) >> 5);
    int it = gw - (base % NGW); if (it < 0) it += NGW;
    for (; it < nitems; it += NGW) tr_item(W, ldw, K, ncols, WT, row_off, mode, gain, it, scr, lane);
    base += nitems;
}
template <bool COPY, bool SECOND>
__device__ __forceinline__ void rms1024(const float* xrow, const float* g1, bf16* o1, const float* g2, bf16* o2, float* cpy, int lane) {
    const f32x4* xr = (const f32x4*)xrow + lane; f32x4 v[4]; float s = 0.f;
#pragma unroll
    for (int j = 0; j < 4; ++j) { v[j] = xr[64 * j]; s += (v[j].x * v[j].x + v[j].y * v[j].y) + (v[j].z * v[j].z + v[j].w * v[j].w); }
    if (COPY) {
#pragma unroll
        for (int j = 0; j < 4; ++j) ((f32x4*)cpy + lane)[64 * j] = v[j]; }
    const float inv = 1.0f / sqrtf(wave_sum(s) * (1.f / 1024.f) + RMS_EPS);
#pragma unroll
    for (int j = 0; j < 4; ++j) { const f32x4 g = ((const f32x4*)g1 + lane)[64 * j]; const f32x4 y = v[j] * inv;
        v2u w; w.x = pk2(y.x * g.x, y.y * g.y); w.y = pk2(y.z * g.z, y.w * g.w); ((v2u*)o1 + lane)[64 * j] = w; }
    if (SECOND) {
#pragma unroll
        for (int j = 0; j < 4; ++j) { const f32x4 g = ((const f32x4*)g2 + lane)[64 * j]; const f32x4 y = v[j] * inv;
            v2u w; w.x = pk2(y.x * g.x, y.y * g.y); w.y = pk2(y.z * g.z, y.w * g.w); ((v2u*)o2 + lane)[64 * j] = w; } }
}

typedef const void* cvp_t;
#define ARGP_EARLY(k) (((const __attribute__((address_space(4))) cvp_t*)__builtin_amdgcn_kernarg_segment_ptr())[k])
struct Args { const void* in[20]; float* out; unsigned char* ws; };

__global__ void __launch_bounds__(NWAVES * 64, 2) yoco_fwd(Args a) {
    extern __shared__ __attribute__((aligned(16))) unsigned char lds[];
    cg::grid_group grid = cg::this_grid();
    LAS unsigned char* ldsp = (LAS unsigned char*)lds;
    const int wave = __builtin_amdgcn_readfirstlane((int)threadIdx.x >> 6);
    const int G = gridDim.x, bx = blockIdx.x; const int vcu = (G % 8 == 0) ? (bx % 8) * (G / 8) + bx / 8 : bx;
    const int gw = bx * NWAVES + wave, NGW = G * NWAVES;
    if (threadIdx.x < 16) ((LAS unsigned*)(ldsp + MISC_OFF))[threadIdx.x] = 0u;
    __syncthreads();
    (void)xcd_barrier_post((unsigned*)((unsigned char*)ARGP_EARLY(21) + WS_CTL), (volatile LAS unsigned*)(ldsp + MISC_OFF));
#define LANE_O() ({ int t_ = threadIdx.x; asm volatile("" : "+v"(t_)); t_ & 63; })
#define TID_O() ({ int t_ = threadIdx.x; asm volatile("" : "+v"(t_)); t_; })
#define ARGP(k) ({ const __attribute__((address_space(4))) cvp_t* p_ = (const __attribute__((address_space(4))) cvp_t*)__builtin_amdgcn_kernarg_segment_ptr(); asm volatile("" : "+s"(p_)); p_[k]; })
#define scr ((LAS float*)(ldsp + wave * 16384))
#define in_x ((const float*)ARGP(0))
#define positions ((const int*)ARGP(1))
#define attn_norm ((const float*)ARGP(2))
#define ffn_norm ((const float*)ARGP(3))
#define w_gate ((const float*)ARGP(4))
#define w_up ((const float*)ARGP(5))
#define w_down ((const float*)ARGP(6))
#define fox_w_in ((const float*)ARGP(7))
#define fox_b_f ((const float*)ARGP(8))
#define fox_w_o ((const float*)ARGP(9))
#define kv_norm ((const float*)ARGP(10))
#define w_kv_a ((const float*)ARGP(11))
#define ckv_norm ((const float*)ARGP(12))
#define w_uk ((const float*)ARGP(13))
#define w_uv ((const float*)ARGP(14))
#define mla_w_dq ((const float*)ARGP(15))
#define cq_norm ((const float*)ARGP(16))
#define mla_w_uq ((const float*)ARGP(17))
#define mla_w_o ((const float*)ARGP(18))
#define final_norm ((const float*)ARGP(19))
#define out ((float*)ARGP(20))
#define ws ((unsigned char*)ARGP(21))
#define XN ((bf16*)(ws + WS_XN))
#define logfT ((float*)(ws + WS_LOGF))
#define cbg ((float*)(ws + WS_CB))
#define cst ((float*)(ws + WS_CS))

#define SSQH ((float*)(ws + WS_SSQH))
#define SSQC ((float*)(ws + WS_SSQC))
#define SSQK ((float*)(ws + WS_SSQK))
#define CONV_A(l_, gw_, ngw_) do { const int L_ = (l_); int base_ = 0; const int lane = LANE_O(); \
        if (L_ < 2) { \
            conv_job(fox_w_in + (size_t)L_ * 1024 * 3088, 3088, 1024, 3088, (bf16*)(ws + W_A), 0, 0, attn_norm + L_ * DM, base_, gw_, ngw_, scr, lane); \
        } else { \
            conv_job(mla_w_dq + (size_t)(L_ - 2) * 1024 * 768, 768, 1024, 768, (bf16*)(ws + W_DQ), 0, 0, attn_norm + L_ * DM, base_, gw_, ngw_, scr, lane); \
            conv_job(mla_w_uq + (size_t)(L_ - 2) * 768 * 1536, 1536, 768, 1536, (bf16*)(ws + W_UQ), 0, 0, cq_norm + (L_ - 2) * 768, base_, gw_, ngw_, scr, lane); \
            if (L_ == 2) { \
                conv_job(w_kv_a, 288, 1024, 288, (bf16*)(ws + W_KVA), 0, 0, kv_norm, base_, gw_, ngw_, scr, lane); \
                conv_job(w_uk, 1024, 256, 1024, (bf16*)(ws + W_UKV), 0, 0, ckv_norm, base_, gw_, ngw_, scr, lane); \
                conv_job(w_uv, 1024, 256, 1024, (bf16*)(ws + W_UKV), 1024, 0, ckv_norm, base_, gw_, ngw_, scr, lane); \
            } \
        } } while (0)
#define CONV_REST(l_, gw_, ngw_) do { const int L_ = (l_); int base_ = 0; const int lane = LANE_O(); \
        conv_job((L_ < 2 ? fox_w_o + (size_t)L_ * 1024 * 1024 : mla_w_o + (size_t)(L_ - 2) * 1024 * 1024), 1024, 1024, 1024, (bf16*)(ws + W_O), 0, 0, nullptr, base_, gw_, ngw_, scr, lane); \
        conv_job(w_gate + (size_t)L_ * 1024 * DFF, DFF, 1024, DFF, (bf16*)(ws + W_GU), 0, 1, ffn_norm + L_ * DM, base_, gw_, ngw_, scr, lane); \
        conv_job(w_up + (size_t)L_ * 1024 * DFF, DFF, 1024, DFF, (bf16*)(ws + W_GU), 0, 2, ffn_norm + L_ * DM, base_, gw_, ngw_, scr, lane); \
        conv_job(w_down + (size_t)L_ * DFF * 1024, 1024, DFF, 1024, (bf16*)(ws + W_DN), 0, 0, nullptr, base_, gw_, ngw_, scr, lane); \
    } while (0)
#define RUN_GEMM(EpiT, E_, Ap, Bp, N_, K_) do { pg8::Gemm g_{(const pg8::bf16_t*)(Ap), (const pg8::bf16_t*)(Bp), SEQ, (N_), (K_)}; pg8::StaticOrder S_; \
        int bxo_ = blockIdx.x, go_ = gridDim.x; asm volatile("" : "+s"(bxo_), "+s"(go_));     \
        S_.init(SEQ, (N_), go_, bxo_); \
        pg8::gemm_phase<EpiT, pg8::StaticOrder, true, true>(ldsp, g_, S_, E_); } while (0)

    CONV_A(0, gw, NGW);
    { const int lane = LANE_O();
    for (int idx = gw * 64 + lane; idx < SEQ * 16; idx += NGW * 64) {
        const int s = idx >> 4, i = idx & 15;
        const float inv_freq = powf(10000.0f, -(float)(2 * i) / 32.0f);
        const float ang = (float)positions[s] * inv_freq;
        const double rev = (double)ang * 0.15915494309189535; const float fr = (float)(rev - rint(rev));
        cst[s * 32 + i] = __builtin_amdgcn_cosf(fr); cst[s * 32 + 16 + i] = __builtin_amdgcn_sinf(fr);
    }
    for (int m = gw; m < SEQ; m += NGW) {
        const f32x4* xr = (const f32x4*)(in_x + (size_t)m * DM) + lane; f32x4 v[4]; float s = 0.f;
#pragma unroll
        for (int j = 0; j < 4; ++j) { v[j] = xr[64 * j]; s += (v[j].x * v[j].x + v[j].y * v[j].y) + (v[j].z * v[j].z + v[j].w * v[j].w); }
#pragma unroll
        for (int j = 0; j < 4; ++j) { v2u w; w.x = pk2(v[j].x, v[j].y); w.y = pk2(v[j].z, v[j].w); ((v2u*)(XN + (size_t)m * DM) + lane)[64 * j] = w; }
        s = wave_sum(s);
        if (lane < 16) SSQH[(size_t)m * 16 + lane] = lane == 0 ? s : 0.f;
    } }
    if (gridDim.x == 0x7fffffffu) grid.sync();
    GSYNC();

#pragma nounroll
    for (int l = 0; l < 4; ++l) {
        const bf16* Optr;
        if (l < 2) {
            { pg8::EpiBf16S E{(pg8::bf16_t*)(ws + WS_Q), 1024, 1024, (size_t)16777216, C2FOX, 1, -1, nullptr, SSQH, 4, 1.f / 1024.f, 0, nullptr};
              RUN_GEMM(pg8::EpiBf16S, E, XN, ws + W_A, 3072, 1024); }
            {
                const int lane = LANE_O(); typedef short fg_bf16x8 __attribute__((ext_vector_type(8))); const float bfv = fox_b_f[l * 16 + (lane & 15)];
                for (int task = gw; task < SEQ / 16; task += NGW) {
                    const int r0 = task * 16;
                    const bf16* ap = XN + (size_t)(r0 + (lane & 15)) * 1024 + 8 * (lane >> 4);
                    const bf16* bp = (const bf16*)(ws + W_A) + (size_t)(3072 + (lane & 15)) * 1024 + 8 * (lane >> 4);
                    f32x4 acc = (f32x4){0.f, 0.f, 0.f, 0.f};
#pragma unroll 8
                    for (int kk = 0; kk < 32; ++kk) { const fg_bf16x8 av = *(const fg_bf16x8*)(ap + kk * 32), bv = *(const fg_bf16x8*)(bp + kk * 32); acc = __builtin_amdgcn_mfma_f32_16x16x32_bf16(av, bv, acc, 0, 0, 0); }
#pragma unroll
                    for (int i = 0; i < 4; ++i) { const int row = r0 + 4 * (lane >> 4) + i; const float xx = acc[i] * pg8::row_inv(SSQH, row, 4, 1.f / 1024.f) + bfv; acc[i] = fminf(xx, 0.f) - __logf(1.f + __expf(-fabsf(xx))); }
                    *(f32x4*)(logfT + (size_t)(lane & 15) * SEQ + r0 + 4 * (lane >> 4)) = acc;
                }
            }
            GSYNC();
            for (int sr2_ = 0; sr2_ < SCAN_REP; ++sr2_) {
            if (bx < 16) {
                const int tid = TID_O(), lane = tid & 63;
                const float* src = logfT + (size_t)bx * SEQ + tid * 32; float v[32]; float run = 0.f;
#pragma unroll
                for (int j = 0; j < 8; ++j) { const f32x4 t4 = *(const f32x4*)(src + 4 * j); run += t4.x; v[4 * j] = run; run += t4.y; v[4 * j + 1] = run; run += t4.z; v[4 * j + 2] = run; run += t4.w; v[4 * j + 3] = run; }
                float inc = run;
#pragma unroll
                for (int o = 1; o < 64; o <<= 1) { const float t = __shfl_up(inc, o); if (lane >= o) inc += t; }
                LAS float* wt = (LAS float*)ldsp;
                if (lane == 63) wt[wave] = inc;
                __syncthreads();
                float off = inc - run;
                for (int w = 0; w < wave; ++w) off += wt[w];
                float* dst = cbg + (size_t)bx * SEQ + tid * 32;
#pragma unroll
                for (int j = 0; j < 8; ++j) *(f32x4*)(dst + 4 * j) = (f32x4){(off + v[4 * j]) * -LOG2E, (off + v[4 * j + 1]) * -LOG2E, (off + v[4 * j + 2]) * -LOG2E, (off + v[4 * j + 3]) * -LOG2E};
                __syncthreads();
            }
            if (bx >= 16 || G <= 16) {
                const int gwc = (G > 16 ? (bx - 16) : bx) * NWAVES + wave, ngwc = (G > 16 ? (G - 16) : G) * NWAVES;
                CONV_REST(l, gwc, ngwc);
                CONV_A(l + 1, gwc, ngwc);
                {
                    const int lane = LANE_O(); float mq = 0.f, mk = 0.f;
                    for (int m0 = gwc * 4; m0 < SEQ; m0 += ngwc * 4) {
                        v4u qv[4][2], kv[4][2];
#pragma unroll
                        for (int r = 0; r < 4; ++r) { const v4u* qp = (const v4u*)((const bf16*)(ws + WS_Q) + (size_t)(m0 + r) * 1024 + lane * 16); const v4u* kp = (const v4u*)((const bf16*)(ws + WS_K) + (size_t)(m0 + r) * 1024 + lane * 16);
                            qv[r][0] = qp[0]; qv[r][1] = qp[1]; kv[r][0] = kp[0]; kv[r][1] = kp[1]; }
#pragma unroll
                        for (int r = 0; r < 4; ++r) { float sq = 0.f, sk = 0.f;
#pragma unroll
                            for (int j = 0; j < 4; ++j) { const float a0 = __uint_as_float(qv[r][0][j] << 16), a1 = __uint_as_float(qv[r][0][j] & 0xffff0000u), a2 = __uint_as_float(qv[r][1][j] << 16), a3 = __uint_as_float(qv[r][1][j] & 0xffff0000u);
                                sq += (a0 * a0 + a1 * a1) + (a2 * a2 + a3 * a3);
                                const float b0 = __uint_as_float(kv[r][0][j] << 16), b1 = __uint_as_float(kv[r][0][j] & 0xffff0000u), b2 = __uint_as_float(kv[r][1][j] << 16), b3 = __uint_as_float(kv[r][1][j] & 0xffff0000u);
                                sk += (b0 * b0 + b1 * b1) + (b2 * b2 + b3 * b3); }
                            sq += __shfl_xor(sq, 1); sq += __shfl_xor(sq, 2); sk += __shfl_xor(sk, 1); sk += __shfl_xor(sk, 2);
                            mq = fmaxf(mq, sq); mk = fmaxf(mk, sk); }
                    }
                    if ((lane & 3) == 0) {
                        unsigned* km = (unsigned*)(ws + WS_CTL + KMAXF_OFF) + l * 64; const unsigned uq = __float_as_uint(mq), uk = __float_as_uint(mk);
                        if (uq > __hip_atomic_load(km + (lane >> 2), __ATOMIC_RELAXED, __HIP_MEMORY_SCOPE_AGENT)) atomicMax(km + (lane >> 2), uq);
                        if (uk > __hip_atomic_load(km + 16 + (lane >> 2), __ATOMIC_RELAXED, __HIP_MEMORY_SCOPE_AGENT)) atomicMax(km + 16 + (lane >> 2), uk); }
                }
            }
            GSYNC();
            }
            for (int rep_ = 0; rep_ < ATT_REPF; ++rep_)
            for (int i = 0;; ++i) { int hh, qb;
                if (G == 256) { if (i >= 4) break; const int s = vcu & 15; hh = ((vcu >> 4) + 4 * i) & 15; qb = (i == 0) ? 63 - s : (i == 1) ? 32 + s : (i == 2) ? 31 - s : s; }
                else { const int j = vcu + i * G; if (j >= 1024) break; hh = j >> 6; qb = 63 - (j & 63); }
                {
                    const float* nbp = cbg + (size_t)hh * SEQ + qb * 256; const float* kmf = (const float*)(ws + WS_CTL + KMAXF_OFF) + l * 64;
                    const float span = 2.f * (sqrtf(kmf[hh] * kmf[16 + hh]) * 1.02f + 0.25f) + (nbp[255] - nbp[0]);
                    const bool fast = __builtin_amdgcn_readfirstlane((int)(span < 118.f)) != 0;
                    if (fast) att::attn_unit<false, true>(hh, qb, (i & 1) != 0, (const GAS bf16*)(ws + WS_Q), (const GAS bf16*)(ws + WS_K), nullptr, (const GAS bf16*)(ws + WS_V), (GAS bf16*)(ws + WS_KN), (const GAS float*)cbg, (const GAS float*)(ws + WS_CTL + KMAXF_OFF) + l * 64, (LAS char*)ldsp);
                    else att::attn_unit<false, false>(hh, qb, (i & 1) != 0, (const GAS bf16*)(ws + WS_Q), (const GAS bf16*)(ws + WS_K), nullptr, (const GAS bf16*)(ws + WS_V), (GAS bf16*)(ws + WS_KN), (const GAS float*)cbg, (const GAS float*)(ws + WS_CTL + KMAXF_OFF) + l * 64, (LAS char*)ldsp);
                } }
            GSYNC();
            Optr = (const bf16*)(ws + WS_KN);
        } else {
            if (l == 2) {
                pg8::EpiNormOut E{(pg8::bf16_t*)(ws + WS_CKV), 256, SSQH, SSQK, -1, nullptr, nullptr, nullptr};
                pg8::Gemm g_{(const pg8::bf16_t*)XN, (const pg8::bf16_t*)(ws + W_KVA), SEQ, 256, 1024}; pg8::StaticOrder S_;
                int bxo_ = blockIdx.x, go_ = gridDim.x; asm volatile("" : "+s"(bxo_), "+s"(go_));
                S_.init(SEQ, 256, go_, go_ == 256 ? ((bxo_ + 64) & 255) : bxo_);
                pg8::gemm_phase<pg8::EpiNormOut, pg8::StaticOrder, true, true>(ldsp, g_, S_, E);
            }
            { pg8::EpiNormOut E{(pg8::bf16_t*)(ws + WS_CQ), 768, SSQH, SSQC, -1, nullptr, nullptr, nullptr}; RUN_GEMM(pg8::EpiNormOut, E, XN, ws + W_DQ, 768, 1024); }
            if (l == 2) {
                const int lane = LANE_O(); typedef short kr_bf16x8 __attribute__((ext_vector_type(8))); const int n = lane & 15; float mr = 0.f;
                for (int task = gw; task < SEQ / 16; task += NGW) {
                    const int r0 = task * 16;
                    const bf16* ap = XN + (size_t)(r0 + n) * 1024 + 8 * (lane >> 4);
                    const bf16* bp1 = (const bf16*)(ws + W_KVA) + (size_t)(256 + n) * 1024 + 8 * (lane >> 4); const bf16* bp2 = bp1 + 16 * 1024;
                    f32x4 acc1 = (f32x4){0.f, 0.f, 0.f, 0.f}, acc2 = acc1;
#pragma unroll 8
                    for (int kk = 0; kk < 32; ++kk) { const kr_bf16x8 av = *(const kr_bf16x8*)(ap + kk * 32), b1 = *(const kr_bf16x8*)(bp1 + kk * 32), b2 = *(const kr_bf16x8*)(bp2 + kk * 32);
                        acc1 = __builtin_amdgcn_mfma_f32_16x16x32_bf16(av, b1, acc1, 0, 0, 0); acc2 = __builtin_amdgcn_mfma_f32_16x16x32_bf16(av, b2, acc2, 0, 0, 0); }
#pragma unroll
                    for (int i = 0; i < 4; ++i) { const int row = r0 + 4 * (lane >> 4) + i; const float rs = pg8::row_inv(SSQH, row, 4, 1.f / 1024.f);
                        const float x1 = acc1[i] * rs, x2 = acc2[i] * rs, c = cst[(size_t)row * 32 + n], s = cst[(size_t)row * 32 + 16 + n];
                        const float o1 = x1 * c - x2 * s, o2 = x1 * s + x2 * c;
                        bf16* kr = (bf16*)(ws + WS_KR) + (size_t)row * 32;
                        kr[n] = (bf16)(pk2(o1, 0.f) & 0xffffu); kr[16 + n] = (bf16)(pk2(o2, 0.f) & 0xffffu);
                        float sr = o1 * o1 + o2 * o2; sr += __shfl_xor(sr, 1); sr += __shfl_xor(sr, 2); sr += __shfl_xor(sr, 4); sr += __shfl_xor(sr, 8);
                        mr = fmaxf(mr, sr); }
                }
                mr = fmaxf(mr, __shfl_xor(mr, 16)); mr = fmaxf(mr, __shfl_xor(mr, 32));
                if (lane == 0) { unsigned* kp = (unsigned*)(ws + WS_CTL + KMAX_OFF) + 32; const unsigned um = __float_as_uint(mr); if (um > __hip_atomic_load(kp, __ATOMIC_RELAXED, __HIP_MEMORY_SCOPE_AGENT)) atomicMax(kp, um); }
            }
            GSYNC();
            if (l == 2) { pg8::EpiBf16S E{(pg8::bf16_t*)(ws + WS_KN), 1024, 1024, (size_t)16777216, 1.f, 0, -1, nullptr, SSQK, 1, 1.f / 256.f, 0, (unsigned*)(ws + WS_CTL + KMAX_OFF)};
                          RUN_GEMM(pg8::EpiBf16S, E, ws + WS_CKV, ws + W_UKV, 2048, 256); }
            { pg8::EpiBf16S E{(pg8::bf16_t*)(ws + WS_QM), 1536, 0, (size_t)0, C2MLA, 1, -1, nullptr, SSQC, 3, 1.f / 768.f, 0, nullptr};
              RUN_GEMM(pg8::EpiBf16S, E, ws + WS_CQ, ws + W_UQ, 1536, 768); }
            GSYNC();
            CONV_REST(l, gw, NGW);
            if (l < 3) CONV_A(l + 1, gw, NGW);
            __syncthreads();
            for (int rep_ = 0; rep_ < ATT_REPM; ++rep_)
            for (int i = 0;; ++i) { int hh, qb;
                if (G == 256) { if (i >= 4) break; const int s = vcu & 15; hh = vcu >> 4; qb = (i == 0) ? 63 - s : (i == 1) ? 32 + s : (i == 2) ? 31 - s : s; }
                else { const int j = vcu + i * G; if (j >= 1024) break; hh = j >> 6; qb = 63 - (j & 63); }
                att::attn_unit<true>(hh, qb, (i & 1) != 0, (const GAS bf16*)(ws + WS_QM), (const GAS bf16*)(ws + WS_KN), (const GAS bf16*)(ws + WS_KR), (const GAS bf16*)(ws + WS_VM), (GAS bf16*)(ws + WS_OM), (const GAS float*)(ws + WS_CTL + KMAX_OFF), (const GAS float*)cst, (LAS char*)ldsp); }
            GSYNC();
            Optr = (const bf16*)(ws + WS_OM);
        }
        { pg8::EpiResAdd E{(pg8::bf16_t*)XN, SSQH, 1024}; RUN_GEMM(pg8::EpiResAdd, E, Optr, ws + W_O, 1024, 1024); }
        GSYNC();
        for (int rg_ = 0; rg_ < GU_REP; ++rg_) { pg8::EpiSwiGLU E{(pg8::bf16_t*)(ws + WS_HH), DFF, SSQH}; RUN_GEMM(pg8::EpiSwiGLU, E, XN, ws + W_GU, 2 * DFF, 1024); }
        GSYNC();
        { pg8::EpiResAdd E{(pg8::bf16_t*)XN, SSQH, 1024}; RUN_GEMM(pg8::EpiResAdd, E, ws + WS_HH, ws + W_DN, 1024, DFF); }
        GSYNC();
    }
    { const int lane = LANE_O();
    for (int m = gw; m < SEQ; m += NGW) {
        const v2u* hr = (const v2u*)(XN + (size_t)m * DM) + lane; f32x4* xr = (f32x4*)(out + (size_t)m * DM) + lane; f32x4 v[4]; float s = 0.f;
#pragma unroll
        for (int j = 0; j < 4; ++j) { const v2u hw = hr[64 * j]; v[j] = (f32x4){__uint_as_float(hw.x << 16), __uint_as_float(hw.x & 0xffff0000u), __uint_as_float(hw.y << 16), __uint_as_float(hw.y & 0xffff0000u)};
            s += (v[j].x * v[j].x + v[j].y * v[j].y) + (v[j].z * v[j].z + v[j].w * v[j].w); }
        const float inv = 1.0f / sqrtf(wave_sum(s) * (1.f / 1024.f) + RMS_EPS);
#pragma unroll
        for (int j = 0; j < 4; ++j) { const f32x4 g = ((const f32x4*)final_norm + lane)[64 * j]; xr[64 * j] = v[j] * inv * g; }
    } }
}

#undef in_x
#undef out
#undef ws
#undef scr
#undef positions
extern "C" void kernel_launch(void* const* d_in, const int* in_sizes, int n_in, void* d_out, int out_size, void* d_ws, size_t ws_size, hipStream_t stream) {
    static int grid = 0;
    if (grid == 0) {
        if (n_in != 20 || out_size != SEQ * DM || ws_size < WS_END) { fprintf(stderr, "kernel_launch: unexpected problem shape (n_in %d, out %d, ws %zu)\n", n_in, out_size, ws_size); grid = -1; return; }
        int dev = 0, cus = 0, per_cu = 0;
        if (hipGetDevice(&dev) != hipSuccess || hipDeviceGetAttribute(&cus, hipDeviceAttributeMultiprocessorCount, dev) != hipSuccess) { grid = -1; return; }
        if (hipFuncSetAttribute((const void*)yoco_fwd, hipFuncAttributeMaxDynamicSharedMemorySize, LDS_BYTES) != hipSuccess) { fprintf(stderr, "kernel_launch: hipFuncSetAttribute failed\n"); grid = -1; return; }
        if (hipOccupancyMaxActiveBlocksPerMultiprocessor(&per_cu, (const void*)yoco_fwd, NWAVES * 64, LDS_BYTES) != hipSuccess || per_cu < 1) per_cu = 1;
        (void)hipGetLastError();
        grid = cus * per_cu;
    }
    if (grid < 0) return;
    if (hipMemsetAsync((char*)d_ws + WS_CTL, 0, CTL_BYTES, stream) != hipSuccess) { fprintf(stderr, "kernel_launch: memset failed\n"); return; }
    Args a{};
    for (int i = 0; i < 20; ++i) a.in[i] = d_in[i];
    a.out = (float*)d_out; a.ws = (unsigned char*)d_ws;
    void* params[] = {&a};
    hipError_t e = hipLaunchCooperativeKernel((const void*)yoco_fwd, dim3(grid), dim3(NWAVES * 64), params, LDS_BYTES, stream);
    if (e != hipSuccess) fprintf(stderr, "cooperative launch failed: %s (grid %d)\n", hipGetErrorString(e), grid);
}
```

```cpp
#include <hip/hip_runtime.h>
#include <hip/hip_cooperative_groups.h>
#include <cstdio>
#include <cstdint>
namespace cg = cooperative_groups;
namespace pg8 {
#define PG8_LAS __attribute__((address_space(3)))
typedef unsigned short bf16_t;
typedef short bf16x8 __attribute__((ext_vector_type(8)));
typedef float f32x4 __attribute__((ext_vector_type(4)));
typedef unsigned u32x4 __attribute__((ext_vector_type(4)));
constexpr int BM = 256, BK = 64, HALF = 128, HTB = HALF * BK * 2  , STAGE_BYTES = 8 * HTB, NXCD = 8, WGM = 8;

__host__ __device__ __forceinline__ int lds_byte(int r, int c) { const int st = (r >> 4) * 2 + (c >> 5), rr = r & 15, cc = c & 31, ob = rr * 64 + cc * 2; return st * 1024 + (ob ^ (((ob >> 9) & 1) << 5)); }
__host__ __device__ __forceinline__ void stage_rc(int b, int& R, int& C) { const int st = b / 1024, sb = b % 1024, swz = sb ^ (((sb >> 9) & 1) << 5); R = (st >> 1) * 16 + swz / 64; C = (st & 1) * 32 + (swz % 64) / 2; }
__host__ __device__ __forceinline__ int perm32(int rho) { const int n = rho >> 4, i = rho & 15; return 8 * (i >> 2) + 4 * n + (i & 3); }

struct Unit { int pm, pn; };
struct Gemm { const bf16_t* A; const bf16_t* Bt; int M, N, K; };

struct StaticOrder {
    int nM, nN, nwg, G, c;
    __host__ __device__ void init(int M, int N, int G_, int c_) { nM = M / BM; nN = N / BM; nwg = nM * nN; G = G_; c = c_; }
    __host__ __device__ bool next(int i, Unit& u) const {
        const long L = (long)i * G + c; if (L >= nwg) return false;
        int wgid = (int)L; { const int q = nwg / NXCD, r = nwg % NXCD, xcd = wgid % NXCD, off = wgid / NXCD; wgid = (xcd < r ? xcd * (q + 1) : r * (q + 1) + (xcd - r) * q) + off; }
        const int nig = WGM * nN, gid = wgid / nig, fm = gid * WGM, gsz = (nM - fm) < WGM ? (nM - fm) : WGM;
        u.pm = fm + ((wgid % nig) % gsz); u.pn = (wgid % nig) / gsz; return true;
    }
    __device__ __forceinline__ void a_ready(const Unit&) const {}
    __device__ __forceinline__ void done(const Unit&) const {}
};

__device__ __forceinline__ unsigned cvt_pk_bf16(float lo, float hi) { unsigned r; asm volatile("v_cvt_pk_bf16_f32 %0, %1, %2" : "=v"(r) : "v"(lo), "v"(hi)); return r; }
typedef float f32x2 __attribute__((ext_vector_type(2)));
typedef unsigned u32x2 __attribute__((ext_vector_type(2)));
__device__ __forceinline__ float row_inv(const float* ssq, int row, int nvec, float inv_n) {
    if (!ssq) return 1.f;
    const f32x4* p = (const f32x4*)(ssq + (size_t)row * 16); f32x4 s = p[0];
    if (nvec > 1) s += p[1];
    if (nvec > 2) s += p[2];
    if (nvec > 3) s += p[3];
    return 1.0f / sqrtf(((s.x + s.y) + (s.z + s.w)) * inv_n + 1e-6f);
}
struct EpiBf16S {
    static constexpr bool PERM = true, AFTER_DRAIN = false;
    bf16_t* O; int ldc; int split_cols; size_t split_stride; float scale0; int nscale;
    int fgate_pn; float* logit;
    const float* ssq; int nvec; float inv_n;
    int kmax_tmax; unsigned* kmax;
    __device__ __forceinline__ void operator()(const f32x4 (&acc)[2][2][4][2], const Unit& u, int wr, int wc, int fr, int fq) const {
        const int row0 = u.pm * BM + wr * 64 + fr;
        if (u.pn == fgate_pn) {
            if (wc == 0 && fq < 2) {
#pragma unroll
                for (int ai = 0; ai < 2; ++ai)
#pragma unroll
                    for (int m = 0; m < 4; ++m) { const int row = row0 + ai * HALF + m * 16; const float rs = row_inv(ssq, row, nvec, inv_n); float* lp = logit + (size_t)row * 16 + 8 * fq;
                        *(f32x4*)lp = acc[ai][0][m][0] * rs; *(f32x4*)(lp + 4) = acc[ai][0][m][1] * rs; }
            }
            return;
        }
        int colt = u.pn * BM; bf16_t* base = O; int t = 0;
        if (split_cols) { t = colt / split_cols; base += (size_t)t * split_stride; colt -= t * split_cols; }
        const float sc = (t < nscale) ? scale0 : 1.f;
        const int col0 = colt + wc * 32 + 8 * fq; float mx[2] = {0.f, 0.f};
#pragma unroll
        for (int ai = 0; ai < 2; ++ai)
#pragma unroll
            for (int m = 0; m < 4; ++m) { const int row = row0 + ai * HALF + m * 16; const float rs = row_inv(ssq, row, nvec, inv_n) * sc; bf16_t* rowp = base + (size_t)row * ldc + col0;
#pragma unroll
                for (int bj = 0; bj < 2; ++bj) { f32x4 v0 = acc[ai][bj][m][0] * rs, v1 = acc[ai][bj][m][1] * rs;
                    if (kmax && t <= kmax_tmax) { float sb = ((v0[0] * v0[0] + v0[1] * v0[1]) + (v0[2] * v0[2] + v0[3] * v0[3])) + ((v1[0] * v1[0] + v1[1] * v1[1]) + (v1[2] * v1[2] + v1[3] * v1[3]));
                        sb += __shfl_xor(sb, 16); sb += __shfl_xor(sb, 32); mx[bj] = fmaxf(mx[bj], sb); }
                    u32x4 w; w.x = cvt_pk_bf16(v0[0], v0[1]); w.y = cvt_pk_bf16(v0[2], v0[3]); w.z = cvt_pk_bf16(v1[0], v1[1]); w.w = cvt_pk_bf16(v1[2], v1[3]);
                    *(u32x4*)(rowp + bj * HALF) = w; } }
        if (kmax && t <= kmax_tmax) {
#pragma unroll
            for (int bj = 0; bj < 2; ++bj) { float mm = mx[bj];
#pragma unroll
                for (int o = 1; o < 16; o <<= 1) mm = fmaxf(mm, __shfl_xor(mm, o));
                if (fr == 0 && fq == 0) { unsigned* kp = kmax + (4 * u.pn + 2 * bj + (wc >> 1)) * 2 + (wc & 1); const unsigned um = __float_as_uint(mm);
                    if (um > __hip_atomic_load(kp, __ATOMIC_RELAXED, __HIP_MEMORY_SCOPE_AGENT)) atomicMax(kp, um); } }
        }
    }
};
__device__ __forceinline__ float silu_mul(float g, float u) { return g * __builtin_amdgcn_rcpf(1.f + __builtin_amdgcn_exp2f(-1.4426950408889634f * g)) * u; }
struct EpiSwiGLU {
    static constexpr bool PERM = true, AFTER_DRAIN = false;
    bf16_t* O; int ldc; const float* ssq;
    __device__ __forceinline__ void operator()(const f32x4 (&acc)[2][2][4][2], const Unit& u, int wr, int wc, int fr, int fq) const {
        const int row0 = u.pm * BM + wr * 64 + fr; const int col0 = u.pn * HALF + wc * 32 + 8 * fq;
#pragma unroll
        for (int ai = 0; ai < 2; ++ai)
#pragma unroll
            for (int m = 0; m < 4; ++m) { const int row = row0 + ai * HALF + m * 16; const float rs = row_inv(ssq, row, 4, 1.f / 1024.f); bf16_t* rowp = O + (size_t)row * ldc + col0;
                const f32x4 g0 = acc[ai][0][m][0] * rs, g1 = acc[ai][0][m][1] * rs, u0 = acc[ai][1][m][0] * rs, u1 = acc[ai][1][m][1] * rs;
                u32x4 w; w.x = cvt_pk_bf16(silu_mul(g0[0], u0[0]), silu_mul(g0[1], u0[1])); w.y = cvt_pk_bf16(silu_mul(g0[2], u0[2]), silu_mul(g0[3], u0[3]));
                w.z = cvt_pk_bf16(silu_mul(g1[0], u1[0]), silu_mul(g1[1], u1[1])); w.w = cvt_pk_bf16(silu_mul(g1[2], u1[2]), silu_mul(g1[3], u1[3]));
                *(u32x4*)rowp = w; }
    }
};
struct EpiResAdd {
    static constexpr bool PERM = true, AFTER_DRAIN = false;
    bf16_t* hb; float* ssq_out; int ldc;
    __device__ __forceinline__ void operator()(const f32x4 (&acc)[2][2][4][2], const Unit& u, int wr, int wc, int fr, int fq) const {
        const int row0 = u.pm * BM + wr * 64 + fr; const int col0 = u.pn * BM + wc * 32 + 8 * fq;
#pragma unroll
        for (int ai = 0; ai < 2; ++ai)
#pragma unroll
            for (int m = 0; m < 4; ++m) { const int row = row0 + ai * HALF + m * 16; bf16_t* hp = hb + (size_t)row * ldc + col0; float ss = 0.f;
#pragma unroll
                for (int bj = 0; bj < 2; ++bj) { u32x4* p = (u32x4*)(hp + bj * HALF); const u32x4 hw = *p;
                    f32x4 v0 = acc[ai][bj][m][0], v1 = acc[ai][bj][m][1];
                    v0[0] += __uint_as_float(hw.x << 16); v0[1] += __uint_as_float(hw.x & 0xffff0000u); v0[2] += __uint_as_float(hw.y << 16); v0[3] += __uint_as_float(hw.y & 0xffff0000u);
                    v1[0] += __uint_as_float(hw.z << 16); v1[1] += __uint_as_float(hw.z & 0xffff0000u); v1[2] += __uint_as_float(hw.w << 16); v1[3] += __uint_as_float(hw.w & 0xffff0000u);
                    ss += ((v0[0] * v0[0] + v0[1] * v0[1]) + (v0[2] * v0[2] + v0[3] * v0[3])) + ((v1[0] * v1[0] + v1[1] * v1[1]) + (v1[2] * v1[2] + v1[3] * v1[3]));
                    u32x4 w; w.x = cvt_pk_bf16(v0[0], v0[1]); w.y = cvt_pk_bf16(v0[2], v0[3]); w.z = cvt_pk_bf16(v1[0], v1[1]); w.w = cvt_pk_bf16(v1[2], v1[3]); *p = w; }
                ss += __shfl_xor(ss, 16); ss += __shfl_xor(ss, 32);
                if (fq == 0) ssq_out[(size_t)row * 16 + 4 * u.pn + wc] = ss; }
    }
};
struct EpiNormOut {
    static constexpr bool PERM = false, AFTER_DRAIN = false;
    bf16_t* O; int ldc; const float* ssq_in; float* ssq_out; int rope_pn; const float* cs; bf16_t* KR; unsigned* kmax;
    __device__ __forceinline__ void operator()(const f32x4 (&acc)[2][2][4][2], const Unit& u, int wr, int wc, int fr, int fq) const {
        const int row0 = u.pm * BM + wr * 64 + fr;
        if (u.pn == rope_pn) {
            if (wc == 0) { float mr = 0.f;
#pragma unroll
                for (int ai = 0; ai < 2; ++ai)
#pragma unroll
                    for (int m = 0; m < 4; ++m) { const int row = row0 + ai * HALF + m * 16; const float rs = row_inv(ssq_in, row, 4, 1.f / 1024.f);
                        const f32x4 x1 = acc[ai][0][m][0] * rs, x2 = acc[ai][0][m][1] * rs; const f32x4 c = *(const f32x4*)(cs + (size_t)row * 32 + 4 * fq), s = *(const f32x4*)(cs + (size_t)row * 32 + 16 + 4 * fq);
                        const f32x4 o1 = x1 * c - x2 * s, o2 = x1 * s + x2 * c;
                        u32x2 w1, w2; w1.x = cvt_pk_bf16(o1[0], o1[1]); w1.y = cvt_pk_bf16(o1[2], o1[3]); w2.x = cvt_pk_bf16(o2[0], o2[1]); w2.y = cvt_pk_bf16(o2[2], o2[3]);
                        *(u32x2*)(KR + (size_t)row * 32 + 4 * fq) = w1; *(u32x2*)(KR + (size_t)row * 32 + 16 + 4 * fq) = w2;
                        float sb = ((o1[0] * o1[0] + o1[1] * o1[1]) + (o1[2] * o1[2] + o1[3] * o1[3])) + ((o2[0] * o2[0] + o2[1] * o2[1]) + (o2[2] * o2[2] + o2[3] * o2[3]));
                        sb += __shfl_xor(sb, 16); sb += __shfl_xor(sb, 32); mr = fmaxf(mr, sb); }
#pragma unroll
                for (int o = 1; o < 16; o <<= 1) mr = fmaxf(mr, __shfl_xor(mr, o));
                if (kmax && fr == 0 && fq == 0) { const unsigned um = __float_as_uint(mr); if (um > __hip_atomic_load(kmax + 32, __ATOMIC_RELAXED, __HIP_MEMORY_SCOPE_AGENT)) atomicMax(kmax + 32, um); }
            }
            return;
        }
        const int col0 = u.pn * BM + wc * 32 + 4 * fq;
#pragma unroll
        for (int ai = 0; ai < 2; ++ai)
#pragma unroll
            for (int m = 0; m < 4; ++m) { const int row = row0 + ai * HALF + m * 16; const float rs = row_inv(ssq_in, row, 4, 1.f / 1024.f); bf16_t* op = O + (size_t)row * ldc + col0; float ss = 0.f;
#pragma unroll
                for (int bj = 0; bj < 2; ++bj)
#pragma unroll
                    for (int n = 0; n < 2; ++n) { const f32x4 v = acc[ai][bj][m][n] * rs; ss += (v[0] * v[0] + v[1] * v[1]) + (v[2] * v[2] + v[3] * v[3]);
                        u32x2 w; w.x = cvt_pk_bf16(v[0], v[1]); w.y = cvt_pk_bf16(v[2], v[3]); *(u32x2*)(op + bj * HALF + n * 16) = w; }
                ss += __shfl_xor(ss, 16); ss += __shfl_xor(ss, 32);
                if (fq == 0) ssq_out[(size_t)row * 16 + 4 * u.pn + wc] = ss; }
    }
};
template <class Epi, class Sched, bool ALIGN_EPI = false, bool SP2 = false>
__device__ __forceinline__ void gemm_phase(PG8_LAS unsigned char* lds, const Gemm g, const Sched& S, const Epi& E) {
    int tid_o = threadIdx.x; asm volatile("" : "+v"(tid_o)); const int tid = tid_o, wid = __builtin_amdgcn_readfirstlane(tid >> 6), lane = tid & 63, wr = wid >> 2, wc = wid & 3, fr = lane & 15, fq = lane >> 4;
    const int K = g.K, nt = K / BK;
    unsigned voffA[2], voffB[2];
#pragma unroll
    for (int i = 0; i < 2; ++i) { int R, C; stage_rc(tid * 16 + i * 8192, R, C); const int Rb = Epi::PERM ? ((R & ~31) + perm32(R & 31)) : R;
        voffA[i] = (unsigned)(R * K + C) * 2u; voffB[i] = (unsigned)(Rb * K + C) * 2u; }
    const size_t kstep = (size_t)(BK * 2);
    const size_t hstep = (size_t)HALF * K * 2;
    const size_t tstep = 2 * hstep;
    const unsigned ldsw = (unsigned)wid * 1024u;
    const int aoff = lds_byte(wr * 64 + fr, fq * 8), boff = lds_byte(wc * 32 + fr, fq * 8);
#define PG8_SA(b, h) (((b) * 2 + (h)) * HTB)
#define PG8_SB(b, h) ((4 + (b) * 2 + (h)) * HTB)
#define PG8_STAGE(bufoff, gbase, voff) do { _Pragma("unroll") for (int _i = 0; _i < 2; ++_i) \
        __builtin_amdgcn_global_load_lds((const unsigned*)((const char*)(gbase) + (voff)[_i]), (PG8_LAS unsigned*)(lds + (bufoff) + ldsw + _i * 8192), 16, 0, 0); } while (0)
#define PG8_LDA(dst, b, h) do { _Pragma("unroll") for (int m = 0; m < 4; ++m) _Pragma("unroll") for (int k = 0; k < 2; ++k) dst[m][k] = *(const PG8_LAS bf16x8*)(lds + PG8_SA(b, h) + aoff + m * 2048 + k * 1024); } while (0)
#define PG8_LDB(dst, b, h) do { _Pragma("unroll") for (int n = 0; n < 2; ++n) _Pragma("unroll") for (int k = 0; k < 2; ++k) dst[n][k] = *(const PG8_LAS bf16x8*)(lds + PG8_SB(b, h) + boff + n * 2048 + k * 1024); } while (0)
#define PG8_MMA(ai, bj, At, Bt) do { __builtin_amdgcn_s_setprio(1); _Pragma("unroll") for (int m = 0; m < 4; ++m) _Pragma("unroll") for (int n = 0; n < 2; ++n) _Pragma("unroll") for (int k = 0; k < 2; ++k) \
        acc[ai][bj][m][n] = __builtin_amdgcn_mfma_f32_16x16x32_bf16(Bt[n][k], At[m][k], acc[ai][bj][m][n], 0, 0, 0); __builtin_amdgcn_s_setprio(0); } while (0)
#define PG8_WAIT_V(n) asm volatile("s_waitcnt vmcnt(" #n ")" ::: "memory")
#define PG8_WAIT_L(n) asm volatile("s_waitcnt lgkmcnt(" #n ")" ::: "memory")
#define PG8_BAR __builtin_amdgcn_s_barrier()
#define PG8_SCHED __builtin_amdgcn_sched_barrier(0)
    Unit cur, nxt; int ui = 0;
    if (!S.next(0, cur)) return;
    f32x4 acc[2][2][4][2];
#pragma unroll
    for (int a = 0; a < 2; ++a)
#pragma unroll
        for (int b = 0; b < 2; ++b)
#pragma unroll
            for (int m = 0; m < 4; ++m)
#pragma unroll
                for (int n = 0; n < 2; ++n) acc[a][b][m][n] = (f32x4){0.f, 0.f, 0.f, 0.f};
    bf16x8 At[4][2], B0[2][2], B1[2][2];
    const char* cA = (const char*)g.A + (size_t)cur.pm * tstep; const char* cB = (const char*)g.Bt + (size_t)cur.pn * tstep;
    S.a_ready(cur);
    if constexpr (SP2) {
        PG8_STAGE(PG8_SB(0, 0), cB, voffB); PG8_STAGE(PG8_SB(0, 1), cB + hstep, voffB); PG8_STAGE(PG8_SA(0, 0), cA, voffA); PG8_STAGE(PG8_SA(0, 1), cA + hstep, voffA);
        if (wr == 1) PG8_BAR;
        PG8_WAIT_V(2); PG8_BAR;
        PG8_STAGE(PG8_SB(1, 0), cB + kstep, voffB); PG8_STAGE(PG8_SA(1, 0), cA + kstep, voffA); PG8_STAGE(PG8_SB(1, 1), cB + hstep + kstep, voffB);
        PG8_WAIT_V(6); PG8_BAR;
    } else {
        PG8_STAGE(PG8_SB(0, 0), cB, voffB); PG8_STAGE(PG8_SA(0, 0), cA, voffA); PG8_STAGE(PG8_SB(0, 1), cB + hstep, voffB); PG8_STAGE(PG8_SA(0, 1), cA + hstep, voffA);
        if (wr == 1) PG8_BAR;
        PG8_WAIT_V(4); PG8_BAR;
        PG8_STAGE(PG8_SB(1, 0), cB + kstep, voffB); PG8_STAGE(PG8_SA(1, 0), cA + kstep, voffA); PG8_STAGE(PG8_SB(1, 1), cB + hstep + kstep, voffB);
        PG8_WAIT_V(6); PG8_BAR;
    }
    for (;;) {
        const bool has_next = S.next(ui + 1, nxt);
        const char* nA = has_next ? (const char*)g.A + (size_t)nxt.pm * tstep : cA; const char* nB = has_next ? (const char*)g.Bt + (size_t)nxt.pn * tstep : cB;
        for (int t = 0; t < nt; t += 2) {
            const bool last = (t == nt - 2);
            const char* a1 = cA + (size_t)(t + 1) * kstep;
            const char* a2 = last ? nA : cA + (size_t)(t + 2) * kstep; const char* b2 = last ? nB : cB + (size_t)(t + 2) * kstep;
            const char* a3 = a2 + kstep; const char* b3 = b2 + kstep;
            if (last && has_next) S.a_ready(nxt);
            if constexpr (SP2) {
            PG8_LDB(B0, 0, 0); PG8_LDB(B1, 0, 1); PG8_SCHED; PG8_LDA(At, 0, 0); PG8_STAGE(PG8_SA(1, 1), a1 + hstep, voffA);
            PG8_WAIT_V(8); PG8_WAIT_L(0); PG8_BAR; PG8_MMA(0, 0, At, B0); PG8_MMA(0, 1, At, B1); PG8_BAR; PG8_SCHED;
            PG8_LDA(At, 0, 1); PG8_STAGE(PG8_SB(0, 0), b2, voffB); PG8_STAGE(PG8_SB(0, 1), b2 + hstep, voffB); PG8_STAGE(PG8_SA(0, 0), a2, voffA);
            PG8_WAIT_V(8); PG8_WAIT_L(0); PG8_BAR; PG8_MMA(1, 0, At, B0); PG8_MMA(1, 1, At, B1); PG8_BAR; PG8_SCHED;
            PG8_LDB(B0, 1, 0); PG8_LDB(B1, 1, 1); PG8_SCHED; PG8_LDA(At, 1, 0); PG8_STAGE(PG8_SA(0, 1), a2 + hstep, voffA);
            PG8_WAIT_V(8); PG8_WAIT_L(0); PG8_BAR; PG8_MMA(0, 0, At, B0); PG8_MMA(0, 1, At, B1); PG8_BAR; PG8_SCHED;
            PG8_LDA(At, 1, 1); PG8_STAGE(PG8_SB(1, 0), b3, voffB); PG8_STAGE(PG8_SB(1, 1), b3 + hstep, voffB); PG8_STAGE(PG8_SA(1, 0), a3, voffA);
            PG8_WAIT_V(8); PG8_WAIT_L(0); PG8_BAR; PG8_MMA(1, 0, At, B0); PG8_MMA(1, 1, At, B1); PG8_BAR; PG8_SCHED;
            } else {
            PG8_LDB(B0, 0, 0); PG8_SCHED; PG8_LDA(At, 0, 0); PG8_STAGE(PG8_SA(1, 1), a1 + hstep, voffA);
            PG8_WAIT_L(8); PG8_BAR; PG8_WAIT_L(0); PG8_MMA(0, 0, At, B0); PG8_BAR; PG8_SCHED;
            PG8_LDB(B1, 0, 1); PG8_STAGE(PG8_SB(0, 0), b2, voffB);
            PG8_BAR; PG8_WAIT_L(0); PG8_MMA(0, 1, At, B1); PG8_BAR;
            PG8_LDA(At, 0, 1); PG8_STAGE(PG8_SA(0, 0), a2, voffA);
            PG8_BAR; PG8_WAIT_L(0); PG8_MMA(1, 0, At, B0); PG8_BAR; PG8_SCHED;
            PG8_STAGE(PG8_SB(0, 1), b2 + hstep, voffB);
            PG8_WAIT_V(6); PG8_BAR; PG8_MMA(1, 1, At, B1); PG8_BAR;
            PG8_LDB(B0, 1, 0); PG8_SCHED; PG8_LDA(At, 1, 0); PG8_STAGE(PG8_SA(0, 1), a2 + hstep, voffA);
            PG8_WAIT_L(8); PG8_BAR; PG8_WAIT_L(0); PG8_MMA(0, 0, At, B0); PG8_BAR; PG8_SCHED;
            PG8_LDB(B1, 1, 1); PG8_STAGE(PG8_SB(1, 0), b3, voffB);
            PG8_BAR; PG8_WAIT_L(0); PG8_MMA(0, 1, At, B1); PG8_BAR;
            PG8_LDA(At, 1, 1); PG8_STAGE(PG8_SA(1, 0), a3, voffA);
            PG8_BAR; PG8_WAIT_L(0); PG8_MMA(1, 0, At, B0); PG8_BAR; PG8_SCHED;
            PG8_STAGE(PG8_SB(1, 1), b3 + hstep, voffB);
            PG8_WAIT_V(6); PG8_BAR; PG8_MMA(1, 1, At, B1); PG8_BAR;
            }
        }
        if constexpr (ALIGN_EPI) { if (wr == 0) PG8_BAR; }
        if constexpr (!Epi::AFTER_DRAIN) { E(acc, cur, wr, wc, fr, fq); S.done(cur); }
        if (!has_next) break;
#pragma unroll
        for (int a = 0; a < 2; ++a)
#pragma unroll
            for (int b = 0; b < 2; ++b)
#pragma unroll
                for (int m = 0; m < 4; ++m)
#pragma unroll
                    for (int n = 0; n < 2; ++n) acc[a][b][m][n] = (f32x4){0.f, 0.f, 0.f, 0.f};
        cur = nxt; cA = nA; cB = nB; ++ui;
        if constexpr (ALIGN_EPI) { if (wr == 1) PG8_BAR; }
    }
    PG8_WAIT_V(0);
    if constexpr (!ALIGN_EPI) { if (wr == 0) PG8_BAR; }
    PG8_BAR;
    if constexpr (Epi::AFTER_DRAIN) { E.fused(acc, cur, wr, wc, fr, fq, lds, wid, lane); S.done(cur); }
#undef PG8_SA
#undef PG8_SB
#undef PG8_STAGE
#undef PG8_LDA
#undef PG8_LDB
#undef PG8_MMA
#undef PG8_WAIT_V
#undef PG8_WAIT_L
#undef PG8_BAR
#undef PG8_SCHED
}
}
namespace att {
#define ALAS __attribute__((address_space(3)))
#define AGAS __attribute__((address_space(1)))
typedef unsigned short bf16;
typedef short bf16x8 __attribute__((ext_vector_type(8)));
typedef short s16x4 __attribute__((ext_vector_type(4)));
typedef short v4i16_t __attribute__((ext_vector_type(4)));
typedef float f32x16 __attribute__((ext_vector_type(16)));
typedef float f32x4 __attribute__((ext_vector_type(4)));
typedef unsigned u32x4 __attribute__((ext_vector_type(4)));
constexpr int SEQ = 16384;
constexpr float THR = 8.f;
#ifndef ATT_PFV
#define ATT_PFV 1
#endif
__device__ __forceinline__ int crow(int r, int hi) { return (r & 3) + 8 * (r >> 2) + 4 * hi; }
typedef float f32x2_t __attribute__((ext_vector_type(2))); typedef __bf16 bf16x2_t __attribute__((ext_vector_type(2)));
__device__ __forceinline__ unsigned cvtpk(float lo, float hi) { f32x2_t v = {lo, hi}; bf16x2_t b = __builtin_convertvector(v, bf16x2_t); return __builtin_bit_cast(unsigned, b); }
__device__ __forceinline__ float bf2f(short v) { return __uint_as_float(((unsigned)(unsigned short)v) << 16); }
__device__ __forceinline__ s16x4 vtr(const ALAS char* p) { return __builtin_bit_cast(s16x4, __builtin_amdgcn_ds_read_tr16_b64_v4i16((ALAS v4i16_t*)p)); }
__device__ __forceinline__ float hmax(float m) { auto rr = __builtin_amdgcn_permlane32_swap(__float_as_uint(m), __float_as_uint(m), false, false); return fmaxf(__uint_as_float(rr[0]), __uint_as_float(rr[1])); }
__device__ __forceinline__ float hsum(float m) { auto rr = __builtin_amdgcn_permlane32_swap(__float_as_uint(m), __float_as_uint(m), false, false); return __uint_as_float(rr[0]) + __uint_as_float(rr[1]); }
__device__ __forceinline__ float max3(float a, float b, float c) { return fmaxf(fmaxf(a, b), c); }
__device__ __forceinline__ float tilemax(const f32x16& p0, const f32x16& p1) {
    float a = max3(p0[0], p0[1], p1[0]), b = max3(p0[2], p0[3], p1[1]); a = max3(a, p1[2], p1[3]);
#pragma unroll
    for (int r = 4; r < 16; r += 4) { a = max3(a, p0[r], p0[r + 1]); b = max3(b, p0[r + 2], p0[r + 3]); a = max3(a, p1[r], p1[r + 1]); b = max3(b, p1[r + 2], p1[r + 3]); }
    return hmax(fmaxf(a, b));
}
__device__ __forceinline__ void cmask(f32x16& p0, f32x16& p1, int jb, int qrel, int hi) {
    const int kbase = 64 * jb + 4 * hi;
#pragma unroll
    for (int r = 0; r < 16; ++r) { const int kv = kbase + (r & 3) + 8 * (r >> 2); if (kv > qrel) p0[r] = -INFINITY; if (kv + 32 > qrel) p1[r] = -INFINITY; }
}
#define ATT_MFMA(a, b, c) __builtin_amdgcn_mfma_f32_32x32x16_bf16(a, b, c, 0, 0, 0)
#define ATT_SGBAR(mask, n) __builtin_amdgcn_sched_group_barrier(mask, n, 0)

template <bool MLA> struct Cfg { static constexpr int NK = MLA ? 6 : 4, KT = MLA ? 12288 : 8192, VT = 8192, STG = 2 * KT + 2 * VT + 512, L_WS = 2 * STG, L_END = L_WS + 2048; };

template <bool MLA, bool FASTREF = false>
__device__ __forceinline__ void attn_unit(int h, int qb, bool rev, const AGAS bf16* Q, const AGAS bf16* __restrict__ Kn, const AGAS bf16* __restrict__ Kr, const AGAS bf16* __restrict__ V, AGAS bf16* O,
                                          const AGAS float* __restrict__ cbg, const AGAS float* __restrict__ cs, ALAS char* shm) {
    typedef Cfg<MLA> C;
    constexpr int QP = MLA ? 1536 : 1024, QH = MLA ? 96 : 64, NK = C::NK, KT = C::KT, VT = C::VT, STG = C::STG;
    int tid_o = threadIdx.x; asm volatile("" : "+v"(tid_o)); const int tid = tid_o, lane = tid & 63, r32 = lane & 31, hi = lane >> 5; const int wid = __builtin_amdgcn_readfirstlane(tid >> 6);
    const int q0 = qb * 256, NI_all = 2 * (qb + 1);
    const AGAS float* cbu = cbg + (size_t)h * SEQ;
    float cbreg = 0.f; float mu = 0.f; (void)cbreg; (void)mu;
    if constexpr (FASTREF) mu = __uint_as_float(__builtin_amdgcn_readfirstlane(__float_as_uint(cbu[q0 + 255] + sqrtf(cs[h] * cs[16 + h]) * 1.02f + 0.25f)));
    ALAS char* kdst = shm + wid * 1024;
    ALAS char* vdst = shm + 2 * KT + wid * 1024;
    ALAS char* krdst = shm + (wid >> 2) * KT + (8 + (wid & 3)) * 1024;
    ALAS char* cbdst = shm + 2 * KT + 2 * VT + (wid & 1) * 256;
#define ATT_GL16(src_, dst_) __builtin_amdgcn_global_load_lds((const AGAS unsigned*)(src_), (ALAS unsigned*)(dst_), 16, 0, 0)
#define ATT_DMA(it_, s_) do { const size_t ko_ = (size_t)(it_) * 128 * 1024; const int so_ = (s_) * STG; \
        int ln_ = __builtin_amdgcn_mbcnt_hi(~0u, __builtin_amdgcn_mbcnt_lo(~0u, 0u)); asm volatile("" : "+v"(ln_)); \
        const AGAS bf16* ks_ = Kn + ko_ + ((unsigned)ln_ * 1024u + (unsigned)(h * 64 + wid * 8)); \
        const AGAS bf16* vs_ = V + ko_ + ((unsigned)(16 * (wid & 3) + (ln_ >> 2)) * 1024u + (unsigned)(h * 64 + (wid >> 2) * 32 + (ln_ & 3) * 8)); \
        ATT_GL16(ks_, kdst + so_); ATT_GL16(ks_ + 64 * 1024, kdst + so_ + KT); ATT_GL16(vs_, vdst + so_); ATT_GL16(vs_ + 64 * 1024, vdst + so_ + VT); \
        if constexpr (MLA) ATT_GL16(Kr + (size_t)(it_) * 128 * 32 + ((unsigned)(64 * (wid >> 2) + ln_) * 32u + (unsigned)((wid & 3) * 8)), krdst + so_); \
        else if constexpr (!FASTREF) { if (wid < 2) __builtin_amdgcn_global_load_lds((const AGAS unsigned*)(cbu + (size_t)(it_) * 128 + ((wid & 1) * 64 + ln_)), (ALAS unsigned*)(cbdst + so_), 4, 0, 0); } \
        else { if (wid < 2) cbreg = cbu[(size_t)(it_) * 128 + ((wid & 1) * 64 + ln_)]; } } while (0)
#define ATT_CBSTORE(s_) do { if constexpr (FASTREF) { if (wid < 2) { int ln_ = __builtin_amdgcn_mbcnt_hi(~0u, __builtin_amdgcn_mbcnt_lo(~0u, 0u)); asm volatile("" : "+v"(ln_)); \
        *(ALAS float*)(cbdst + (s_) * STG + 4 * ln_) = cbreg - mu; } } } while (0)
#define ATT_SYNC() do { asm volatile("s_waitcnt vmcnt(0)" ::: "memory"); __syncthreads(); } while (0)
    const bool dma_early = MLA || rev;
    if (dma_early) ATT_DMA(rev ? NI_all - 1 : 0, 0);
    const AGAS bf16* Qw = Q + (size_t)(q0 + wid * 32 + r32) * QP + h * QH;
    bf16x8 qr[NK];
#pragma unroll
    for (int d0 = 0; d0 < NK; ++d0) qr[d0] = *(const AGAS bf16x8*)(Qw + d0 * 16 + hi * 8);
    if constexpr (MLA) {
        const AGAS float* cp = cs + (size_t)(q0 + wid * 32 + r32) * 32 + hi * 8;
        const f32x4 c0 = *(const AGAS f32x4*)cp, c1 = *(const AGAS f32x4*)(cp + 4), s0 = *(const AGAS f32x4*)(cp + 16), s1 = *(const AGAS f32x4*)(cp + 20);
        bf16x8 a = qr[4], b = qr[5]; unsigned oa[4], ob[4];
#pragma unroll
        for (int j = 0; j < 8; j += 2) {
            const float x1a = bf2f(a[j]), x2a = bf2f(b[j]), x1b = bf2f(a[j + 1]), x2b = bf2f(b[j + 1]);
            const float ca = j < 4 ? c0[j] : c1[j - 4], cb_ = j < 4 ? c0[j + 1] : c1[j - 3], sa = j < 4 ? s0[j] : s1[j - 4], sb = j < 4 ? s0[j + 1] : s1[j - 3];
            oa[j / 2] = cvtpk(x1a * ca - x2a * sa, x1b * cb_ - x2b * sb);
            ob[j / 2] = cvtpk(x1a * sa + x2a * ca, x1b * sb + x2b * cb_);
        }
        qr[4] = __builtin_bit_cast(bf16x8, (u32x4){oa[0], oa[1], oa[2], oa[3]});
        qr[5] = __builtin_bit_cast(bf16x8, (u32x4){ob[0], ob[1], ob[2], ob[3]});
    }
    int it0 = 0;
    if constexpr (!MLA) {
        const AGAS float* cbu_s = cbg + (size_t)h * SEQ;
        const float thr = __uint_as_float(__builtin_amdgcn_readfirstlane(__float_as_uint(cbg[(size_t)h * SEQ + q0 + (FASTREF ? 255 : 0)] - 150.0f)));
        const int ntile = 2 * NI_all;
        const int j1 = 4 * lane + 3; const float v1 = j1 < ntile ? cbu_s[64 * j1 + 63] : 3.0e38f;
        const int g = __builtin_ctzll(__ballot(v1 >= thr));
        const int j2 = 4 * g + (lane & 3); const float v2 = j2 < ntile ? cbu_s[64 * j2 + 63] : 3.0e38f;
        const int lo = 4 * g + __builtin_ctzll(__ballot(v2 >= thr) | 8ull);
        it0 = __builtin_amdgcn_readfirstlane(lo >> 1);
        if (it0 > NI_all - 2) it0 = NI_all - 2;
    }
    const int NI = NI_all;
    if (!dma_early) ATT_DMA(it0, 0);
    ATT_CBSTORE(0);
    ATT_SYNC();
    ALAS float* wsf = (ALAS float*)(shm + C::L_WS) + wid * 64;
    const ALAS char* kb0 = shm + hi * 1024 + r32 * 16;
    const ALAS char* vp0 = shm + 2 * KT + ((lane >> 4) & 1) * 32 + (lane & 3) * 8 + (4 * hi + ((lane & 15) >> 2)) * 64;
    const ALAS float* cb0 = (const ALAS float*)(shm + 2 * KT + 2 * VT) + 4 * hi;
    float mhat = -3.0e38f, l_reg = 0.f; f32x16 o0 = f32x16{}, o1 = f32x16{};
    if constexpr (!MLA && !FASTREF) {
        float qn = 0.f;
#pragma unroll
        for (int d0 = 0; d0 < NK; ++d0)
#pragma unroll
            for (int j = 0; j < 8; ++j) { const float qv = bf2f(qr[d0][j]); qn += qv * qv; }
        qn = hsum(qn);
        mhat = cbg[(size_t)h * SEQ + q0 + wid * 32 + r32] + sqrtf(qn * cs[16 + h]) * 1.02f + 0.25f;
    }
    f32x16 negm = f32x16{};
    if constexpr (MLA) {
        float qn = 0.f;
#pragma unroll
        for (int d0 = 0; d0 < NK; ++d0)
#pragma unroll
            for (int j = 0; j < 8; ++j) { const float qv = bf2f(qr[d0][j]); qn += qv * qv; }
        qn = hsum(qn);
        const float k2 = cbg[2 * h] + cbg[2 * h + 1] + cbg[32];
        mhat = sqrtf(qn * k2) * 1.02f + 0.25f;
#pragma unroll
        for (int r = 0; r < 16; ++r) negm[r] = -mhat;
        asm volatile("" : "+v"(negm));
    }
    const int qrel = wid * 32 + r32;

#define ATT_LOADK(KF, P0, P1, s_, j_) do { const ALAS char* kb_ = kb0 + (s_) * STG + (j_) * KT; \
        _Pragma("unroll") for (int d0 = 0; d0 < NK; ++d0) { KF[2 * d0] = *(const ALAS bf16x8*)(kb_ + d0 * 2048); KF[2 * d0 + 1] = *(const ALAS bf16x8*)(kb_ + d0 * 2048 + 512); } \
        if constexpr (!MLA) { const ALAS float* cbt_ = cb0 + (s_) * (STG / 4) + 64 * (j_); \
            _Pragma("unroll") for (int g = 0; g < 4; ++g) { const f32x4 ca_ = *(const ALAS f32x4*)(cbt_ + 8 * g), cb2_ = *(const ALAS f32x4*)(cbt_ + 32 + 8 * g); \
                _Pragma("unroll") for (int i = 0; i < 4; ++i) { P0[4 * g + i] = ca_[i]; P1[4 * g + i] = cb2_[i]; } } } \
        else { P0 = negm; P1 = negm; } } while (0)
#define ATT_MMAQK(P0, P1, KF) do { _Pragma("unroll") for (int d0 = 0; d0 < NK; ++d0) { P0 = ATT_MFMA(KF[2 * d0], qr[d0], P0); P1 = ATT_MFMA(KF[2 * d0 + 1], qr[d0], P1); } } while (0)
#define ATT_DECIDE(P0, P1, need_) do { const float rm_ = tilemax(P0, P1); need_ = __any(rm_ > mhat + THR); \
        if (need_) { const float mn_ = fmaxf(mhat, rm_); const float f_ = __builtin_amdgcn_exp2f(mhat - mn_); mhat = mn_; l_reg *= f_; if (hi == 0) wsf[r32] = f_; } } while (0)
#define ATT_ORESC() do { _Pragma("unroll") for (int g = 0; g < 4; ++g) { const f32x4 fv_ = *(const ALAS f32x4*)(wsf + 8 * g + 4 * hi); \
        _Pragma("unroll") for (int i = 0; i < 4; ++i) { o0[4 * g + i] *= fv_[i]; o1[4 * g + i] *= fv_[i]; } } } while (0)
#define ATT_EXP(P0, P1, PA) do { float sa_ = 0.f, sb_ = 0.f; \
        _Pragma("unroll") for (int r = 0; r < 16; ++r) { if constexpr (MLA || FASTREF) { P0[r] = __builtin_amdgcn_exp2f(P0[r]); P1[r] = __builtin_amdgcn_exp2f(P1[r]); } else { P0[r] = __builtin_amdgcn_exp2f(P0[r] - mhat); P1[r] = __builtin_amdgcn_exp2f(P1[r] - mhat); } sa_ += P0[r]; asm("" : "+v"(sa_)); sb_ += P1[r]; asm("" : "+v"(sb_)); } \
        l_reg += sa_ + sb_; \
        PA[0] = __builtin_bit_cast(bf16x8, (u32x4){cvtpk(P0[0], P0[1]), cvtpk(P0[2], P0[3]), cvtpk(P0[4], P0[5]), cvtpk(P0[6], P0[7])}); \
        PA[1] = __builtin_bit_cast(bf16x8, (u32x4){cvtpk(P0[8], P0[9]), cvtpk(P0[10], P0[11]), cvtpk(P0[12], P0[13]), cvtpk(P0[14], P0[15])}); \
        PA[2] = __builtin_bit_cast(bf16x8, (u32x4){cvtpk(P1[0], P1[1]), cvtpk(P1[2], P1[3]), cvtpk(P1[4], P1[5]), cvtpk(P1[6], P1[7])}); \
        PA[3] = __builtin_bit_cast(bf16x8, (u32x4){cvtpk(P1[8], P1[9]), cvtpk(P1[10], P1[11]), cvtpk(P1[12], P1[13]), cvtpk(P1[14], P1[15])}); } while (0)
#define ATT_VF(vp_, d0, ks) ({ const s16x4 lo_ = vtr(vp_ + (d0) * 4096 + (ks) * 1024), hi_ = vtr(vp_ + (d0) * 4096 + (ks) * 1024 + 512); (bf16x8){lo_[0], lo_[1], lo_[2], lo_[3], hi_[0], hi_[1], hi_[2], hi_[3]}; })
#define ATT_LOADV(VF, s_, j_) do { const ALAS char* vp_ = vp0 + (s_) * STG + (j_) * VT; \
        _Pragma("unroll") for (int ks = 0; ks < 4; ++ks) { VF[2 * ks] = ATT_VF(vp_, 0, ks); VF[2 * ks + 1] = ATT_VF(vp_, 1, ks); } } while (0)
#define ATT_MMAPV(PA, VF) do { _Pragma("unroll") for (int ks = 0; ks < 4; ++ks) { o0 = ATT_MFMA(PA[ks], VF[2 * ks], o0); o1 = ATT_MFMA(PA[ks], VF[2 * ks + 1], o1); } } while (0)
#define ATT_INTERVAL(s_, BAND_, ib_) do { \
        f32x16 a0, a1, b0, b1; bf16x8 pa[4], pb[4], kfA[2 * NK], kfB[2 * NK], vfA[8], vfB[8]; \
        int ln_ = __builtin_amdgcn_mbcnt_hi(~0u, __builtin_amdgcn_mbcnt_lo(~0u, 0u)); asm volatile("" : "+v"(ln_));     \
        const int hi = ln_ >> 5, r32 = ln_ & 31; const int qrel = wid * 32 + r32; (void)qrel; \
        const ALAS char* kb0 = shm + hi * 1024 + r32 * 16; \
        const ALAS char* vp0 = shm + 2 * KT + ((ln_ >> 4) & 1) * 32 + (ln_ & 3) * 8 + (4 * hi + ((ln_ & 15) >> 2)) * 64; \
        const ALAS float* cb0 = (const ALAS float*)(shm + 2 * KT + 2 * VT) + 4 * hi; (void)cb0; \
          \
        __builtin_amdgcn_sched_barrier(0); \
        ATT_LOADK(kfA, a0, a1, s_, 0); \
        ATT_LOADK(kfB, b0, b1, s_, 1); \
        __builtin_amdgcn_sched_barrier(0); \
        ATT_MMAQK(a0, a1, kfA); \
        ATT_MMAQK(b0, b1, kfB); \
        __builtin_amdgcn_sched_barrier(0); \
        if (BAND_) { cmask(a0, a1, 2 * (ib_), qrel, hi); cmask(b0, b1, 2 * (ib_) + 1, qrel, hi); } \
        ATT_LOADV(vfA, s_, 0); \
        ATT_LOADV(vfB, s_, 1); \
        __builtin_amdgcn_sched_barrier(0); \
        ATT_EXP(a0, a1, pa); \
        ATT_EXP(b0, b1, pb); \
        asm volatile("" : "+v"(pa[0]), "+v"(pa[1]), "+v"(pa[2]), "+v"(pa[3]), "+v"(pb[0]), "+v"(pb[1]), "+v"(pb[2]), "+v"(pb[3]), "+v"(l_reg)); \
        __builtin_amdgcn_sched_barrier(0); \
        ATT_MMAPV(pa, vfA); \
        ATT_MMAPV(pb, vfB); \
        __builtin_amdgcn_sched_barrier(0); \
    } while (0)

    const int nint = NI - it0;
    for (int k = 0; k < nint; ++k) {
        const int it = rev ? NI - 1 - k : it0 + k, itn = rev ? it - 1 : it + 1, cur = k & 1, ib = it - (NI - 2);
        if (k + 1 < nint) ATT_DMA(itn, cur ^ 1);
        if (ib < 0) { if (cur == 0) ATT_INTERVAL(0, false, 0); else ATT_INTERVAL(1, false, 0); }
        else if (ib == 0 || wid >= 4) { if (cur == 0) ATT_INTERVAL(0, true, ib); else ATT_INTERVAL(1, true, ib); }
        if (k + 1 < nint) ATT_CBSTORE(cur ^ 1);
        ATT_SYNC();
    }
    l_reg = hsum(l_reg);
    if (hi == 0) wsf[32 + r32] = l_reg;
    float rli[16];
#pragma unroll
    for (int g = 0; g < 4; ++g) { const f32x4 lv = *(const ALAS f32x4*)(wsf + 32 + 8 * g + 4 * hi);
#pragma unroll
        for (int i = 0; i < 4; ++i) rli[4 * g + i] = __builtin_amdgcn_rcpf(lv[i]); }
    AGAS bf16* Ow = O + (size_t)(q0 + wid * 32) * 1024 + h * 64;
    ALAS bf16* stg = (ALAS bf16*)shm + wid * 2048;
#pragma unroll
    for (int r = 0; r < 16; ++r) { const int orow = crow(r, hi);
        stg[orow * 64 + r32] = (bf16)(cvtpk(o0[r] * rli[r], 0.f) & 0xffffu);
        stg[orow * 64 + 32 + r32] = (bf16)(cvtpk(o1[r] * rli[r], 0.f) & 0xffffu); }
#pragma unroll
    for (int i = 0; i < 4; ++i) { const int row = i * 8 + (lane >> 3), ch = lane & 7; const u32x4 v = *(const ALAS u32x4*)(stg + row * 64 + ch * 8); *(AGAS u32x4*)(Ow + (size_t)row * 1024 + ch * 8) = v; }
    __syncthreads();
#undef ATT_GL16
#undef ATT_DMA
#undef ATT_CBSTORE
#undef ATT_SYNC
#undef ATT_LOADK
#undef ATT_MMAQK
#undef ATT_LOADV
#undef ATT_MMAPV
#undef ATT_DECIDE
#undef ATT_ORESC
#undef ATT_EXP
#undef ATT_VF
#undef ATT_INTERVAL
}
#undef ALAS
#undef AGAS
}
#define GAS __attribute__((address_space(1)))
#define LAS __attribute__((address_space(3)))
typedef unsigned short bf16;
typedef unsigned v4u __attribute__((ext_vector_type(4)));
typedef unsigned v2u __attribute__((ext_vector_type(2)));
typedef float f32x4 __attribute__((ext_vector_type(4)));
#define XB_TMO      128
#define XB_XCNT(j)  (256  + 64 * (j))
#define XB_XSUB(j)  (1280 + 64 * (j))
#define XB_XGEN(j)  (2304 + 64 * (j))
#define XB_TOP      3328
#define XB_TOPGEN   3392
#define XCD_BAR_WORDS 3456
#define XB_SPIN_CAP (1u << 18)

__device__ __forceinline__ unsigned xb_ld(unsigned* p)              { return __hip_atomic_load(p, __ATOMIC_RELAXED, __HIP_MEMORY_SCOPE_AGENT); }
__device__ __forceinline__ unsigned xb_add(unsigned* p, unsigned v) { return __hip_atomic_fetch_add(p, v, __ATOMIC_RELAXED, __HIP_MEMORY_SCOPE_AGENT); }
__device__ __forceinline__ unsigned xb_xcc_id() { return (unsigned)__builtin_amdgcn_s_getreg((3 << 11) | 20) & 0xFu; }
#define XB_SPIN(cond, bar) do { unsigned _sp = 0; while (cond) { __builtin_amdgcn_s_sleep(1); \
    if ((++_sp & 255u) == 0u) { if (xb_ld(&(bar)[XB_TMO])) break; if (_sp > XB_SPIN_CAP) { atomicAdd(&(bar)[XB_TMO], 1u); break; } } } } while (0)

struct XcdBarrier {
    unsigned* bar; unsigned x;
    volatile LAS unsigned* st;
};

__device__ __forceinline__ XcdBarrier xcd_barrier_post(unsigned* bar, volatile LAS unsigned* st) {
    XcdBarrier b; b.bar = bar; b.x = xb_xcc_id(); b.st = st;
    if (threadIdx.x == 0) (void)xb_add(&bar[XB_XCNT(b.x)], 1u);
    return b;
}
__device__ __forceinline__ void xcd_barrier_complete(unsigned* bar, unsigned x, unsigned& nloc, unsigned& nx) {
    const unsigned G = gridDim.x * gridDim.y * gridDim.z;
    unsigned sum, cnt, mine, sp = 0u;
    for (;;) {
        sum = 0u; cnt = 0u; mine = 0u;
#pragma unroll
        for (unsigned j = 0; j < 16; ++j) { const unsigned c = xb_ld(&bar[XB_XCNT(j)]); sum += c; cnt += (c > 0u) ? 1u : 0u; mine = (j == x) ? c : mine; }
        if (sum == G) break;
        __builtin_amdgcn_s_sleep(1);
        if ((++sp & 255u) == 0u) { if (xb_ld(&bar[XB_TMO])) break; if (sp > XB_SPIN_CAP) { atomicAdd(&bar[XB_TMO], 1u); break; } }
    }
    nloc = mine > 0u ? mine : 1u; nx = cnt > 0u ? cnt : 1u;
}

__device__ __forceinline__ void xcd_barrier(const XcdBarrier& b) {
    asm volatile("s_waitcnt vmcnt(0)" ::: "memory");
    __syncthreads();
    if (threadIdx.x == 0) {
        unsigned* bar = b.bar;
        __builtin_amdgcn_s_waitcnt(0);
        unsigned nloc = b.st[0], nx = b.st[1];
        if (nloc == 0u) { xcd_barrier_complete(bar, b.x, nloc, nx); b.st[0] = nloc; b.st[1] = nx; }
        const unsigned old = xb_add(&bar[XB_XSUB(b.x)], 1u);
        const unsigned gen = old / nloc;
        if (old + 1u == (gen + 1u) * nloc) {
            __builtin_amdgcn_fence(__ATOMIC_RELEASE, "agent");
            asm volatile("s_waitcnt vmcnt(0)" ::: "memory");
            const unsigned og = xb_add(&bar[XB_TOP], 1u);
            const unsigned tg = og / nx;
            if (og + 1u == (tg + 1u) * nx) xb_add(&bar[XB_TOPGEN], 1u);
            else XB_SPIN(xb_ld(&bar[XB_TOPGEN]) == tg, bar);
            __builtin_amdgcn_fence(__ATOMIC_ACQUIRE, "agent");
            xb_add(&bar[XB_XGEN(b.x)], 1u);
            asm volatile("s_waitcnt vmcnt(0)" ::: "memory");
        } else {
            XB_SPIN(xb_ld(&bar[XB_XGEN(b.x)]) == gen, bar);
            __builtin_amdgcn_fence(__ATOMIC_ACQUIRE, "agent");
            asm volatile("s_waitcnt vmcnt(0)" ::: "memory");
        }
    }
    __syncthreads();
}
constexpr int SEQ = 16384, DM = 1024, DFF = 2816, NWAVES = 8;
constexpr int LDS_BYTES = 147456;
#ifndef SYNC_REP
#define SYNC_REP 1
#endif
#define GSYNC() do { for (int sr_ = 0; sr_ < SYNC_REP; ++sr_) { XcdBarrier b_; b_.bar = (unsigned*)(ws + WS_CTL); b_.x = xb_xcc_id(); b_.st = (volatile LAS unsigned*)(ldsp + MISC_OFF); xcd_barrier(b_); } } while (0)
#ifndef SCAN_REP
#define SCAN_REP 1
#endif
#ifndef GU_REP
#define GU_REP 1
#endif
#ifndef ATT_REPF
#define ATT_REPF 1
#endif
#ifndef ATT_REPM
#define ATT_REPM 1
#endif
constexpr float RMS_EPS = 1e-6f;
constexpr float LOG2E = 1.4426950408889634f;
constexpr float C2FOX = 0.125f * LOG2E;
constexpr float C2MLA = 0.10206207261596575f * LOG2E;
constexpr size_t MiB = 1u << 20;
constexpr size_t W_GU = 0, W_DN = 11 * MiB, W_O = 16 * MiB + 512 * 1024, W_A = 18 * MiB + 512 * 1024;
constexpr size_t W_DQ = W_A, W_UQ = 20 * MiB, W_KVA = 23 * MiB, W_UKV = 24 * MiB;
constexpr size_t WS_XN = 26 * MiB, WS_BIG = 58 * MiB;
constexpr size_t WS_Q = WS_BIG, WS_K = WS_BIG + 32 * MiB, WS_V = WS_BIG + 64 * MiB;
constexpr size_t WS_HH = WS_BIG;
constexpr size_t WS_CQ = WS_BIG + 48 * MiB, WS_QM = WS_BIG, WS_OM = WS_BIG + 48 * MiB;
constexpr size_t WS_CKV = WS_BIG + 80 * MiB;
constexpr size_t WS_KN = 154 * MiB, WS_VM = 186 * MiB, WS_KR = 218 * MiB, WS_CS = 219 * MiB, WS_LOGF = 221 * MiB, WS_CB = 222 * MiB, WS_CTL = 223 * MiB, WS_SSQH = 224 * MiB, WS_SSQC = 225 * MiB, WS_SSQK = 226 * MiB, WS_END = 227 * MiB;
constexpr int MISC_OFF = LDS_BYTES - 64, CTL_BYTES = 16384, KMAX_OFF = 14336, KMAXF_OFF = 14592;

__device__ __forceinline__ float wave_sum(float v) {
#pragma unroll
    for (int o = 1; o < 64; o <<= 1) v += __shfl_xor(v, o);
    return v;
}
__device__ __forceinline__ unsigned pk2(float lo, float hi) { return pg8::cvt_pk_bf16(lo, hi); }

__device__ __forceinline__ void tr_item(const float* W, int ldw, int Kd, int ncols, bf16* WT, int row_off, int mode, const float* gain, int item, LAS float* scr, int lane) {
    const int nblk = (ncols + 31) >> 5, kb = item / nblk, nb = item - kb * nblk, k0 = 64 * kb, n0 = 32 * nb;
    {
        const int c4 = n0 + 4 * (lane & 7); const bool cv = c4 < ncols; const float* src = W + (size_t)(k0 + (lane >> 3)) * ldw + c4;
#pragma unroll
        for (int i = 0; i < 8; ++i) { const f32x4 v = cv ? __builtin_nontemporal_load((const f32x4*)(src + (size_t)(8 * i) * ldw)) : (f32x4){0.f, 0.f, 0.f, 0.f};
            LAS float* d = scr + ((lane >> 3) + 8 * i) * 33 + 4 * (lane & 7); d[0] = v.x; d[1] = v.y; d[2] = v.z; d[3] = v.w; }
    }
    asm volatile("s_waitcnt lgkmcnt(0)" ::: "memory");
    const int c8 = lane & 7;
    f32x4 ga = (f32x4){1.f, 1.f, 1.f, 1.f}, gb = ga;
    if (gain) { ga = *(const f32x4*)(gain + k0 + 8 * c8); gb = *(const f32x4*)(gain + k0 + 8 * c8 + 4); }
#pragma unroll
    for (int j = 0; j < 4; ++j) { const int nl = (lane >> 3) + 8 * j, n = n0 + nl; const LAS float* s = scr + (8 * c8) * 33 + nl;
        v4u o; o.x = pk2(s[0 * 33] * ga.x, s[1 * 33] * ga.y); o.y = pk2(s[2 * 33] * ga.z, s[3 * 33] * ga.w); o.z = pk2(s[4 * 33] * gb.x, s[5 * 33] * gb.y); o.w = pk2(s[6 * 33] * gb.z, s[7 * 33] * gb.w);
        const int row = mode == 0 ? row_off + n : (256 * (n >> 7) + (n & 127) + (mode == 2 ? 128 : 0));
        if (n < ncols) *(v4u*)(WT + (size_t)row * Kd + k0 + 8 * c8) = o; }
    asm volatile("s_waitcnt lgkmcnt(0)" ::: "memory");
}
__device__ __forceinline__ void conv_job(const float* W, int ldw, int K, int ncols, bf16* WT, int row_off, int mode, const float* gain, int& base, int gw, int NGW, LAS float* scr, int lane) {
    const int nitems = (K >> 6) * ((ncols + 31) >> 5);
    int it = gw - (base % NGW); if (it < 0) it += NGW;
    for (; it < nitems; it += NGW) tr_item(W, ldw, K, ncols, WT, row_off, mode, gain, it, scr, lane);
    base += nitems;
}
template <bool COPY, bool SECOND>
__device__ __forceinline__ void rms1024(const float* xrow, const float* g1, bf16* o1, const float* g2, bf16* o2, float* cpy, int lane) {
    const f32x4* xr = (const f32x4*)xrow + lane; f32x4 v[4]; float s = 0.f;
#pragma unroll
    for (int j = 0; j < 4; ++j) { v[j] = xr[64 * j]; s += (v[j].x * v[j].x + v[j].y * v[j].y) + (v[j].z * v[j].z + v[j].w * v[j].w); }
    if (COPY) {
#pragma unroll
        for (int j = 0; j < 4; ++j) ((f32x4*)cpy + lane)[64 * j] = v[j]; }
    const float inv = 1.0f / sqrtf(wave_sum(s) * (1.f / 1024.f) + RMS_EPS);
#pragma unroll
    for (int j = 0; j < 4; ++j) { const f32x4 g = ((const f32x4*)g1 + lane)[64 * j]; const f32x4 y = v[j] * inv;
        v2u w; w.x = pk2(y.x * g.x, y.y * g.y); w.y = pk2(y.z * g.z, y.w * g.w); ((v2u*)o1 + lane)[64 * j] = w; }
    if (SECOND) {
#pragma unroll
        for (int j = 0; j < 4; ++j) { const f32x4 g = ((const f32x4*)g2 + lane)[64 * j]; const f32x4 y = v[j] * inv;
            v2u w; w.x = pk2(y.x * g.x, y.y * g.y); w.y = pk2(y.z * g.z, y.w * g.w); ((v2u*)o2 + lane)[64 * j] = w; } }
}

typedef const void* cvp_t;
#define ARGP_EARLY(k) (((const __attribute__((address_space(4))) cvp_t*)__builtin_amdgcn_kernarg_segment_ptr())[k])
struct Args { const void* in[20]; float* out; unsigned char* ws; };

__global__ void __launch_bounds__(NWAVES * 64, 2) yoco_fwd(Args a) {
    extern __shared__ __attribute__((aligned(16))) unsigned char lds[];
    cg::grid_group grid = cg::this_grid();
    LAS unsigned char* ldsp = (LAS unsigned char*)lds;
    const int wave = __builtin_amdgcn_readfirstlane((int)threadIdx.x >> 6);
    const int G = gridDim.x, bx = blockIdx.x; const int vcu = (G % 8 == 0) ? (bx % 8) * (G / 8) + bx / 8 : bx;
    const int gw = bx * NWAVES + wave, NGW = G * NWAVES;
    if (threadIdx.x < 16) ((LAS unsigned*)(ldsp + MISC_OFF))[threadIdx.x] = 0u;
    __syncthreads();
    (void)xcd_barrier_post((unsigned*)((unsigned char*)ARGP_EARLY(21) + WS_CTL), (volatile LAS unsigned*)(ldsp + MISC_OFF));
#define LANE_O() ({ int t_ = threadIdx.x; asm volatile("" : "+v"(t_)); t_ & 63; })
#define TID_O() ({ int t_ = threadIdx.x; asm volatile("" : "+v"(t_)); t_; })
#define ARGP(k) ({ const __attribute__((address_space(4))) cvp_t* p_ = (const __attribute__((address_space(4))) cvp_t*)__builtin_amdgcn_kernarg_segment_ptr(); asm volatile("" : "+s"(p_)); p_[k]; })
#define scr ((LAS float*)(ldsp + wave * 16384))
#define in_x ((const float*)ARGP(0))
#define positions ((const int*)ARGP(1))
#define attn_norm ((const float*)ARGP(2))
#define ffn_norm ((const float*)ARGP(3))
#define w_gate ((const float*)ARGP(4))
#define w_up ((const float*)ARGP(5))
#define w_down ((const float*)ARGP(6))
#define fox_w_in ((const float*)ARGP(7))
#define fox_b_f ((const float*)ARGP(8))
#define fox_w_o ((const float*)ARGP(9))
#define kv_norm ((const float*)ARGP(10))
#define w_kv_a ((const float*)ARGP(11))
#define ckv_norm ((const float*)ARGP(12))
#define w_uk ((const float*)ARGP(13))
#define w_uv ((const float*)ARGP(14))
#define mla_w_dq ((const float*)ARGP(15))
#define cq_norm ((const float*)ARGP(16))
#define mla_w_uq ((const float*)ARGP(17))
#define mla_w_o ((const float*)ARGP(18))
#define final_norm ((const float*)ARGP(19))
#define out ((float*)ARGP(20))
#define ws ((unsigned char*)ARGP(21))
#define XN ((bf16*)(ws + WS_XN))
#define logfT ((float*)(ws + WS_LOGF))
#define cbg ((float*)(ws + WS_CB))
#define cst ((float*)(ws + WS_CS))

#define SSQH ((float*)(ws + WS_SSQH))
#define SSQC ((float*)(ws + WS_SSQC))
#define SSQK ((float*)(ws + WS_SSQK))
#define CONV_A(l_, gw_, ngw_) do { const int L_ = (l_); int base_ = 0; const int lane = LANE_O(); \
        if (L_ < 2) { \
            conv_job(fox_w_in + (size_t)L_ * 1024 * 3088, 3088, 1024, 3088, (bf16*)(ws + W_A), 0, 0, attn_norm + L_ * DM, base_, gw_, ngw_, scr, lane); \
        } else { \
            conv_job(mla_w_dq + (size_t)(L_ - 2) * 1024 * 768, 768, 1024, 768, (bf16*)(ws + W_DQ), 0, 0, attn_norm + L_ * DM, base_, gw_, ngw_, scr, lane); \
            conv_job(mla_w_uq + (size_t)(L_ - 2) * 768 * 1536, 1536, 768, 1536, (bf16*)(ws + W_UQ), 0, 0, cq_norm + (L_ - 2) * 768, base_, gw_, ngw_, scr, lane); \
            if (L_ == 2) { \
                conv_job(w_kv_a, 288, 1024, 288, (bf16*)(ws + W_KVA), 0, 0, kv_norm, base_, gw_, ngw_, scr, lane); \
                conv_job(w_uk, 1024, 256, 1024, (bf16*)(ws + W_UKV), 0, 0, ckv_norm, base_, gw_, ngw_, scr, lane); \
                conv_job(w_uv, 1024, 256, 1024, (bf16*)(ws + W_UKV), 1024, 0, ckv_norm, base_, gw_, ngw_, scr, lane); \
            } \
        } } while (0)
#define CONV_REST(l_, gw_, ngw_) do { const int L_ = (l_); int base_ = 0; const int lane = LANE_O(); \
        conv_job((L_ < 2 ? fox_w_o + (size_t)L_ * 1024 * 1024 : mla_w_o + (size_t)(L_ - 2) * 1024 * 1024), 1024, 1024, 1024, (bf16*)(ws + W_O), 0, 0, nullptr, base_, gw_, ngw_, scr, lane); \
        conv_job(w_gate + (size_t)L_ * 1024 * DFF, DFF, 1024, DFF, (bf16*)(ws + W_GU), 0, 1, ffn_norm + L_ * DM, base_, gw_, ngw_, scr, lane); \
        conv_job(w_up + (size_t)L_ * 1024 * DFF, DFF, 1024, DFF, (bf16*)(ws + W_GU), 0, 2, ffn_norm + L_ * DM, base_, gw_, ngw_, scr, lane); \
        conv_job(w_down + (size_t)L_ * DFF * 1024, 1024, DFF, 1024, (bf16*)(ws + W_DN), 0, 0, nullptr, base_, gw_, ngw_, scr, lane); \
    } while (0)
#define RUN_GEMM(EpiT, E_, Ap, Bp, N_, K_) do { pg8::Gemm g_{(const pg8::bf16_t*)(Ap), (const pg8::bf16_t*)(Bp), SEQ, (N_), (K_)}; pg8::StaticOrder S_; \
        int bxo_ = blockIdx.x, go_ = gridDim.x; asm volatile("" : "+s"(bxo_), "+s"(go_));     \
        S_.init(SEQ, (N_), go_, bxo_); \
        pg8::gemm_phase<EpiT, pg8::StaticOrder, true, true>(ldsp, g_, S_, E_); } while (0)

    CONV_A(0, gw, NGW);
    { const int lane = LANE_O();
    for (int idx = gw * 64 + lane; idx < SEQ * 16; idx += NGW * 64) {
        const int s = idx >> 4, i = idx & 15;
        const float inv_freq = powf(10000.0f, -(float)(2 * i) / 32.0f);
        const float ang = (float)positions[s] * inv_freq;
        const double rev = (double)ang * 0.15915494309189535; const float fr = (float)(rev - rint(rev));
        cst[s * 32 + i] = __builtin_amdgcn_cosf(fr); cst[s * 32 + 16 + i] = __builtin_amdgcn_sinf(fr);
    }
    for (int m = gw; m < SEQ; m += NGW) {
        const f32x4* xr = (const f32x4*)(in_x + (size_t)m * DM) + lane; f32x4 v[4]; float s = 0.f;
#pragma unroll
        for (int j = 0; j < 4; ++j) { v[j] = __builtin_nontemporal_load(xr + 64 * j); s += (v[j].x * v[j].x + v[j].y * v[j].y) + (v[j].z * v[j].z + v[j].w * v[j].w); }
#pragma unroll
        for (int j = 0; j < 4; ++j) { v2u w; w.x = pk2(v[j].x, v[j].y); w.y = pk2(v[j].z, v[j].w); ((v2u*)(XN + (size_t)m * DM) + lane)[64 * j] = w; }
        s = wave_sum(s);
        if (lane < 16) SSQH[(size_t)m * 16 + lane] = lane == 0 ? s : 0.f;
    } }
    if (gridDim.x == 0x7fffffffu) grid.sync();
    GSYNC();

#pragma nounroll
    for (int l = 0; l < 4; ++l) {
        const bf16* Optr;
        if (l < 2) {
            { pg8::EpiBf16S E{(pg8::bf16_t*)(ws + WS_Q), 1024, 1024, (size_t)16777216, C2FOX, 1, -1, nullptr, SSQH, 4, 1.f / 1024.f, 0, nullptr};
              RUN_GEMM(pg8::EpiBf16S, E, XN, ws + W_A, 3072, 1024); }
            {
                const int lane = LANE_O(); typedef short fg_bf16x8 __attribute__((ext_vector_type(8))); const float bfv = fox_b_f[l * 16 + (lane & 15)];
                for (int task = gw; task < SEQ / 16; task += NGW) {
                    const int r0 = task * 16;
                    const bf16* ap = XN + (size_t)(r0 + (lane & 15)) * 1024 + 8 * (lane >> 4);
                    const bf16* bp = (const bf16*)(ws + W_A) + (size_t)(3072 + (lane & 15)) * 1024 + 8 * (lane >> 4);
                    f32x4 acc = (f32x4){0.f, 0.f, 0.f, 0.f};
#pragma unroll 8
                    for (int kk = 0; kk < 32; ++kk) { const fg_bf16x8 av = *(const fg_bf16x8*)(ap + kk * 32), bv = *(const fg_bf16x8*)(bp + kk * 32); acc = __builtin_amdgcn_mfma_f32_16x16x32_bf16(av, bv, acc, 0, 0, 0); }
#pragma unroll
                    for (int i = 0; i < 4; ++i) { const int row = r0 + 4 * (lane >> 4) + i; const float xx = acc[i] * pg8::row_inv(SSQH, row, 4, 1.f / 1024.f) + bfv; acc[i] = fminf(xx, 0.f) - __logf(1.f + __expf(-fabsf(xx))); }
                    *(f32x4*)(logfT + (size_t)(lane & 15) * SEQ + r0 + 4 * (lane >> 4)) = acc;
                }
            }
            GSYNC();
            for (int sr2_ = 0; sr2_ < SCAN_REP; ++sr2_) {
            if (bx < 16) {
                const int tid = TID_O(), lane = tid & 63;
                const float* src = logfT + (size_t)bx * SEQ + tid * 32; float v[32]; float run = 0.f;
#pragma unroll
                for (int j = 0; j < 8; ++j) { const f32x4 t4 = *(const f32x4*)(src + 4 * j); run += t4.x; v[4 * j] = run; run += t4.y; v[4 * j + 1] = run; run += t4.z; v[4 * j + 2] = run; run += t4.w; v[4 * j + 3] = run; }
                float inc = run;
#pragma unroll
                for (int o = 1; o < 64; o <<= 1) { const float t = __shfl_up(inc, o); if (lane >= o) inc += t; }
                LAS float* wt = (LAS float*)ldsp;
                if (lane == 63) wt[wave] = inc;
                __syncthreads();
                float off = inc - run;
                for (int w = 0; w < wave; ++w) off += wt[w];
                float* dst = cbg + (size_t)bx * SEQ + tid * 32;
#pragma unroll
                for (int j = 0; j < 8; ++j) *(f32x4*)(dst + 4 * j) = (f32x4){(off + v[4 * j]) * -LOG2E, (off + v[4 * j + 1]) * -LOG2E, (off + v[4 * j + 2]) * -LOG2E, (off + v[4 * j + 3]) * -LOG2E};
                __syncthreads();
            }
            if (bx >= 16 || G <= 16) {
                const int gwc = (G > 16 ? (bx - 16) : bx) * NWAVES + wave, ngwc = (G > 16 ? (G - 16) : G) * NWAVES;
                CONV_REST(l, gwc, ngwc);
                CONV_A(l + 1, gwc, ngwc);
                {
                    const int lane = LANE_O(); float mq = 0.f, mk = 0.f;
                    for (int m0 = gwc * 4; m0 < SEQ; m0 += ngwc * 4) {
                        v4u qv[4][2], kv[4][2];
#pragma unroll
                        for (int r = 0; r < 4; ++r) { const v4u* qp = (const v4u*)((const bf16*)(ws + WS_Q) + (size_t)(m0 + r) * 1024 + lane * 16); const v4u* kp = (const v4u*)((const bf16*)(ws + WS_K) + (size_t)(m0 + r) * 1024 + lane * 16);
                            qv[r][0] = qp[0]; qv[r][1] = qp[1]; kv[r][0] = kp[0]; kv[r][1] = kp[1]; }
#pragma unroll
                        for (int r = 0; r < 4; ++r) { float sq = 0.f, sk = 0.f;
#pragma unroll
                            for (int j = 0; j < 4; ++j) { const float a0 = __uint_as_float(qv[r][0][j] << 16), a1 = __uint_as_float(qv[r][0][j] & 0xffff0000u), a2 = __uint_as_float(qv[r][1][j] << 16), a3 = __uint_as_float(qv[r][1][j] & 0xffff0000u);
                                sq += (a0 * a0 + a1 * a1) + (a2 * a2 + a3 * a3);
                                const float b0 = __uint_as_float(kv[r][0][j] << 16), b1 = __uint_as_float(kv[r][0][j] & 0xffff0000u), b2 = __uint_as_float(kv[r][1][j] << 16), b3 = __uint_as_float(kv[r][1][j] & 0xffff0000u);
                                sk += (b0 * b0 + b1 * b1) + (b2 * b2 + b3 * b3); }
                            sq += __shfl_xor(sq, 1); sq += __shfl_xor(sq, 2); sk += __shfl_xor(sk, 1); sk += __shfl_xor(sk, 2);
                            mq = fmaxf(mq, sq); mk = fmaxf(mk, sk); }
                    }
                    if ((lane & 3) == 0) {
                        unsigned* km = (unsigned*)(ws + WS_CTL + KMAXF_OFF) + l * 64; const unsigned uq = __float_as_uint(mq), uk = __float_as_uint(mk);
                        if (uq > __hip_atomic_load(km + (lane >> 2), __ATOMIC_RELAXED, __HIP_MEMORY_SCOPE_AGENT)) atomicMax(km + (lane >> 2), uq);
                        if (uk > __hip_atomic_load(km + 16 + (lane >> 2), __ATOMIC_RELAXED, __HIP_MEMORY_SCOPE_AGENT)) atomicMax(km + 16 + (lane >> 2), uk); }
                }
            }
            GSYNC();
            }
            for (int rep_ = 0; rep_ < ATT_REPF; ++rep_)
            for (int i = 0;; ++i) { int hh, qb;
                if (G == 256) { if (i >= 4) break; const int s = vcu & 15; hh = ((vcu >> 4) + 4 * i) & 15; qb = (i == 0) ? 63 - s : (i == 1) ? 32 + s : (i == 2) ? 31 - s : s; }
                else { const int j = vcu + i * G; if (j >= 1024) break; hh = j >> 6; qb = 63 - (j & 63); }
                {
                    const float* nbp = cbg + (size_t)hh * SEQ + qb * 256; const float* kmf = (const float*)(ws + WS_CTL + KMAXF_OFF) + l * 64;
                    const float span = 2.f * (sqrtf(kmf[hh] * kmf[16 + hh]) * 1.02f + 0.25f) + (nbp[255] - nbp[0]);
                    const bool fast = __builtin_amdgcn_readfirstlane((int)(span < 118.f)) != 0;
                    if (fast) att::attn_unit<false, true>(hh, qb, (i & 1) != 0, (const GAS bf16*)(ws + WS_Q), (const GAS bf16*)(ws + WS_K), nullptr, (const GAS bf16*)(ws + WS_V), (GAS bf16*)(ws + WS_KN), (const GAS float*)cbg, (const GAS float*)(ws + WS_CTL + KMAXF_OFF) + l * 64, (LAS char*)ldsp);
                    else att::attn_unit<false, false>(hh, qb, (i & 1) != 0, (const GAS bf16*)(ws + WS_Q), (const GAS bf16*)(ws + WS_K), nullptr, (const GAS bf16*)(ws + WS_V), (GAS bf16*)(ws + WS_KN), (const GAS float*)cbg, (const GAS float*)(ws + WS_CTL + KMAXF_OFF) + l * 64, (LAS char*)ldsp);
                } }
            GSYNC();
            Optr = (const bf16*)(ws + WS_KN);
        } else {
            if (l == 2) {
                pg8::EpiNormOut E{(pg8::bf16_t*)(ws + WS_CKV), 256, SSQH, SSQK, -1, nullptr, nullptr, nullptr};
                pg8::Gemm g_{(const pg8::bf16_t*)XN, (const pg8::bf16_t*)(ws + W_KVA), SEQ, 256, 1024}; pg8::StaticOrder S_;
                int bxo_ = blockIdx.x, go_ = gridDim.x; asm volatile("" : "+s"(bxo_), "+s"(go_));
                S_.init(SEQ, 256, go_, go_ == 256 ? ((bxo_ + 64) & 255) : bxo_);
                pg8::gemm_phase<pg8::EpiNormOut, pg8::StaticOrder, true, true>(ldsp, g_, S_, E);
            }
            { pg8::EpiNormOut E{(pg8::bf16_t*)(ws + WS_CQ), 768, SSQH, SSQC, -1, nullptr, nullptr, nullptr}; RUN_GEMM(pg8::EpiNormOut, E, XN, ws + W_DQ, 768, 1024); }
            if (l == 2) {
                const int lane = LANE_O(); typedef short kr_bf16x8 __attribute__((ext_vector_type(8))); const int n = lane & 15; float mr = 0.f;
                for (int task = gw; task < SEQ / 16; task += NGW) {
                    const int r0 = task * 16;
                    const bf16* ap = XN + (size_t)(r0 + n) * 1024 + 8 * (lane >> 4);
                    const bf16* bp1 = (const bf16*)(ws + W_KVA) + (size_t)(256 + n) * 1024 + 8 * (lane >> 4); const bf16* bp2 = bp1 + 16 * 1024;
                    f32x4 acc1 = (f32x4){0.f, 0.f, 0.f, 0.f}, acc2 = acc1;
#pragma unroll 8
                    for (int kk = 0; kk < 32; ++kk) { const kr_bf16x8 av = *(const kr_bf16x8*)(ap + kk * 32), b1 = *(const kr_bf16x8*)(bp1 + kk * 32), b2 = *(const kr_bf16x8*)(bp2 + kk * 32);
                        acc1 = __builtin_amdgcn_mfma_f32_16x16x32_bf16(av, b1, acc1, 0, 0, 0); acc2 = __builtin_amdgcn_mfma_f32_16x16x32_bf16(av, b2, acc2, 0, 0, 0); }
#pragma unroll
                    for (int i = 0; i < 4; ++i) { const int row = r0 + 4 * (lane >> 4) + i; const float rs = pg8::row_inv(SSQH, row, 4, 1.f / 1024.f);
                        const float x1 = acc1[i] * rs, x2 = acc2[i] * rs, c = cst[(size_t)row * 32 + n], s = cst[(size_t)row * 32 + 16 + n];
                        const float o1 = x1 * c - x2 * s, o2 = x1 * s + x2 * c;
                        bf16* kr = (bf16*)(ws + WS_KR) + (size_t)row * 32;
                        kr[n] = (bf16)(pk2(o1, 0.f) & 0xffffu); kr[16 + n] = (bf16)(pk2(o2, 0.f) & 0xffffu);
                        float sr = o1 * o1 + o2 * o2; sr += __shfl_xor(sr, 1); sr += __shfl_xor(sr, 2); sr += __shfl_xor(sr, 4); sr += __shfl_xor(sr, 8);
                        mr = fmaxf(mr, sr); }
                }
                mr = fmaxf(mr, __shfl_xor(mr, 16)); mr = fmaxf(mr, __shfl_xor(mr, 32));
                if (lane == 0) { unsigned* kp = (unsigned*)(ws + WS_CTL + KMAX_OFF) + 32; const unsigned um = __float_as_uint(mr); if (um > __hip_atomic_load(kp, __ATOMIC_RELAXED, __HIP_MEMORY_SCOPE_AGENT)) atomicMax(kp, um); }
            }
            GSYNC();
            if (l == 2) { pg8::EpiBf16S E{(pg8::bf16_t*)(ws + WS_KN), 1024, 1024, (size_t)16777216, 1.f, 0, -1, nullptr, SSQK, 1, 1.f / 256.f, 0, (unsigned*)(ws + WS_CTL + KMAX_OFF)};
                          RUN_GEMM(pg8::EpiBf16S, E, ws + WS_CKV, ws + W_UKV, 2048, 256); }
            { pg8::EpiBf16S E{(pg8::bf16_t*)(ws + WS_QM), 1536, 0, (size_t)0, C2MLA, 1, -1, nullptr, SSQC, 3, 1.f / 768.f, 0, nullptr};
              RUN_GEMM(pg8::EpiBf16S, E, ws + WS_CQ, ws + W_UQ, 1536, 768); }
            GSYNC();
            CONV_REST(l, gw, NGW);
            if (l < 3) CONV_A(l + 1, gw, NGW);
            __syncthreads();
            for (int rep_ = 0; rep_ < ATT_REPM; ++rep_)
            for (int i = 0;; ++i) { int hh, qb;
                if (G == 256) { if (i >= 4) break; const int s = vcu & 15; hh = vcu >> 4; qb = (i == 0) ? 63 - s : (i == 1) ? 32 + s : (i == 2) ? 31 - s : s; }
                else { const int j = vcu + i * G; if (j >= 1024) break; hh = j >> 6; qb = 63 - (j & 63); }
                att::attn_unit<true>(hh, qb, (i & 1) != 0, (const GAS bf16*)(ws + WS_QM), (const GAS bf16*)(ws + WS_KN), (const GAS bf16*)(ws + WS_KR), (const GAS bf16*)(ws + WS_VM), (GAS bf16*)(ws + WS_OM), (const GAS float*)(ws + WS_CTL + KMAX_OFF), (const GAS float*)cst, (LAS char*)ldsp); }
            GSYNC();
            Optr = (const bf16*)(ws + WS_OM);
        }
        { pg8::EpiResAdd E{(pg8::bf16_t*)XN, SSQH, 1024}; RUN_GEMM(pg8::EpiResAdd, E, Optr, ws + W_O, 1024, 1024); }
        GSYNC();
        for (int rg_ = 0; rg_ < GU_REP; ++rg_) { pg8::EpiSwiGLU E{(pg8::bf16_t*)(ws + WS_HH), DFF, SSQH}; RUN_GEMM(pg8::EpiSwiGLU, E, XN, ws + W_GU, 2 * DFF, 1024); }
        GSYNC();
        { pg8::EpiResAdd E{(pg8::bf16_t*)XN, SSQH, 1024}; RUN_GEMM(pg8::EpiResAdd, E, ws + WS_HH, ws + W_DN, 1024, DFF); }
        GSYNC();
    }
    { const int lane = LANE_O();
    for (int m = gw; m < SEQ; m += NGW) {
        const v2u* hr = (const v2u*)(XN + (size_t)m * DM) + lane; f32x4* xr = (f32x4*)(out + (size_t)m * DM) + lane; f32x4 v[4]; float s = 0.f;
#pragma unroll
        for (int j = 0; j < 4; ++j) { const v2u hw = __builtin_nontemporal_load(hr + 64 * j); v[j] = (f32x4){__uint_as_float(hw.x << 16), __uint_as_float(hw.x & 0xffff0000u), __uint_as_float(hw.y << 16), __uint_as_float(hw.y & 0xffff0000u)};
            s += (v[j].x * v[j].x + v[j].y * v[j].y) + (v[j].z * v[j].z + v[j].w * v[j].w); }
        const float inv = 1.0f / sqrtf(wave_sum(s) * (1.f / 1024.f) + RMS_EPS);
#pragma unroll
        for (int j = 0; j < 4; ++j) { const f32x4 g = ((const f32x4*)final_norm + lane)[64 * j]; xr[64 * j] = v[j] * inv * g; }
    } }
}

#undef in_x
#undef out
#undef ws
#undef scr
#undef positions
extern "C" void kernel_launch(void* const* d_in, const int* in_sizes, int n_in, void* d_out, int out_size, void* d_ws, size_t ws_size, hipStream_t stream) {
    static int grid = 0;
    if (grid == 0) {
        if (n_in != 20 || out_size != SEQ * DM || ws_size < WS_END) { fprintf(stderr, "kernel_launch: unexpected problem shape (n_in %d, out %d, ws %zu)\n", n_in, out_size, ws_size); grid = -1; return; }
        int dev = 0, cus = 0, per_cu = 0;
        if (hipGetDevice(&dev) != hipSuccess || hipDeviceGetAttribute(&cus, hipDeviceAttributeMultiprocessorCount, dev) != hipSuccess) { grid = -1; return; }
        if (hipFuncSetAttribute((const void*)yoco_fwd, hipFuncAttributeMaxDynamicSharedMemorySize, LDS_BYTES) != hipSuccess) { fprintf(stderr, "kernel_launch: hipFuncSetAttribute failed\n"); grid = -1; return; }
        if (hipOccupancyMaxActiveBlocksPerMultiprocessor(&per_cu, (const void*)yoco_fwd, NWAVES * 64, LDS_BYTES) != hipSuccess || per_cu < 1) per_cu = 1;
        (void)hipGetLastError();
        grid = cus * per_cu;
    }
    if (grid < 0) return;
    if (hipMemsetAsync((char*)d_ws + WS_CTL, 0, CTL_BYTES, stream) != hipSuccess) { fprintf(stderr, "kernel_launch: memset failed\n"); return; }
    Args a{};
    for (int i = 0; i < 20; ++i) a.in[i] = d_in[i];
    a.out = (float*)d_out; a.ws = (unsigned char*)d_ws;
    void* params[] = {&a};
    hipError_t e = hipLaunchCooperativeKernel((const void*)yoco_fwd, dim3(grid), dim3(NWAVES * 64), params, LDS_BYTES, stream);
    if (e != hipSuccess) fprintf(stderr, "cooperative launch failed: %s (grid %d)\n", hipGetErrorString(e), grid);
}
```
